# Optimizing an MI355X kernel written in HIP

```python
import jax, jax.numpy as jnp
from jax import lax
import numpy as np

D_MODEL = 2048
BATCH = 4
SEQ = 2048
DEPTH = 2

N_MIXERS = 2
N_MOBA_LAYERS = (DEPTH + 1) // 2
N_RET_LAYERS = DEPTH // 2

FFN_DIM = 5632
FFN_RES = 0.5
RMS_EPS = 1e-6

MOBA_HEADS = 16
MOBA_HEAD_DIM = D_MODEL // MOBA_HEADS
MOBA_BLOCK = 256
MOBA_TOPK = 3
MOBA_Q_CHUNK = 16
ROPE_THETA = 500000.0
ROPE_DIM = MOBA_HEAD_DIM // 4

RET_HEADS = 8
RET_KEY_DIM = D_MODEL // RET_HEADS
RET_VAL_DIM = D_MODEL // RET_HEADS
RET_CHUNK = 128
RET_ROT_BASE = 10000.0

kernel_name = "hybrid_moba_retention_macaron"


def rms_norm(x, g):
    xf = x.astype(jnp.float32)
    y = xf * lax.rsqrt(jnp.mean(xf * xf, axis=-1, keepdims=True) + RMS_EPS)
    return (y * g.astype(jnp.float32)).astype(x.dtype)


def swiglu(x, w_gate_up, w_down):
    g, u = jnp.split(x @ w_gate_up, 2, axis=-1)
    return (jax.nn.silu(g) * u) @ w_down


def rotary(x, pos, rot_dim, inv_freq):
    half = rot_dim // 2
    ang = pos.astype(jnp.float32)[:, None] * inv_freq[None, :]
    cos = jnp.cos(ang).astype(x.dtype)
    sin = jnp.sin(ang).astype(x.dtype)
    x1 = x[..., :half]
    x2 = x[..., half:rot_dim]
    return jnp.concatenate([x1 * cos - x2 * sin, x1 * sin + x2 * cos, x[..., rot_dim:]], axis=-1)


def moba_attention(h, w_qkv, w_o):
    B, S, _ = h.shape
    H, Dh, BLK, QC = MOBA_HEADS, MOBA_HEAD_DIM, MOBA_BLOCK, MOBA_Q_CHUNK
    qkv = (h @ w_qkv).reshape(B, S, 3, H, Dh)
    q = jnp.transpose(qkv[:, :, 0], (0, 2, 1, 3))
    k = jnp.transpose(qkv[:, :, 1], (0, 2, 1, 3))
    v = jnp.transpose(qkv[:, :, 2], (0, 2, 1, 3))
    pos = jnp.arange(S)
    half = ROPE_DIM // 2
    inv_freq = jnp.power(jnp.float32(ROPE_THETA), -jnp.arange(half, dtype=jnp.float32) / half)
    q = rotary(q, pos, ROPE_DIM, inv_freq)
    k = rotary(k, pos, ROPE_DIM, inv_freq)

    n_blk = -(-S // BLK)
    pad = n_blk * BLK - S
    kp = jnp.pad(k, ((0, 0), (0, 0), (0, pad), (0, 0)))
    vp = jnp.pad(v, ((0, 0), (0, 0), (0, pad), (0, 0)))
    k_blocks = kp.reshape(B, H, n_blk, BLK, Dh)
    v_blocks = vp.reshape(B, H, n_blk, BLK, Dh)

    k_mean = jnp.mean(k_blocks.astype(jnp.float32), axis=3)
    gate = jnp.einsum('bhsd,bhnd->bhsn', q.astype(jnp.float32), k_mean)
    q_blk = pos // BLK
    past = jnp.arange(n_blk)[None, :] < q_blk[:, None]
    gate = jnp.where(past[None, None], gate, -jnp.inf)
    k_sel = min(MOBA_TOPK, n_blk)
    _, sel = lax.top_k(gate, k_sel)
    sel_valid = sel < q_blk[None, None, :, None]

    n_qc = S // QC
    q_c_all = q.reshape(B, H, n_qc, QC, Dh).transpose(2, 0, 1, 3, 4)
    sel_all = sel.reshape(B, H, n_qc, QC, k_sel).transpose(2, 0, 1, 3, 4)
    val_all = sel_valid.reshape(B, H, n_qc, QC, k_sel).transpose(2, 0, 1, 3, 4)
    bi = jnp.arange(B)[:, None, None, None]
    hi = jnp.arange(H)[None, :, None, None]
    scale = Dh ** -0.5

    def chunk(args):
        c, q_c, sel_c, val_c = args
        q_start = c * QC
        own = q_start // BLK
        k_own = lax.dynamic_slice_in_dim(kp, own * BLK, BLK, axis=2)
        v_own = lax.dynamic_slice_in_dim(vp, own * BLK, BLK, axis=2)
        k_g = k_blocks[bi, hi, sel_c]
        v_g = v_blocks[bi, hi, sel_c]
        s_sel = jnp.einsum('bhqd,bhqjkd->bhqjk', q_c, k_g).astype(jnp.float32) * scale
        s_sel = jnp.where(val_c[..., None], s_sel, -jnp.inf).reshape(B, H, QC, k_sel * BLK)
        s_own = jnp.einsum('bhqd,bhkd->bhqk', q_c, k_own).astype(jnp.float32) * scale
        qpos = q_start + jnp.arange(QC)
        kpos = own * BLK + jnp.arange(BLK)
        s_own = jnp.where(kpos[None, :] <= qpos[:, None], s_own, -jnp.inf)
        p = jax.nn.softmax(jnp.concatenate([s_sel, s_own], axis=-1), axis=-1).astype(v.dtype)
        p_sel = p[..., :k_sel * BLK].reshape(B, H, QC, k_sel, BLK)
        p_own = p[..., k_sel * BLK:]
        return (jnp.einsum('bhqjk,bhqjkd->bhqd', p_sel, v_g)
                + jnp.einsum('bhqk,bhkd->bhqd', p_own, v_own))

    out = lax.map(chunk, (jnp.arange(n_qc), q_c_all, sel_all, val_all))
    out = out.transpose(1, 0, 3, 2, 4).reshape(B, S, H * Dh)
    return out @ w_o


def retention(h, w_in, w_o, gn_gain):
    B, S, _ = h.shape
    H, dk, dv, C = RET_HEADS, RET_KEY_DIM, RET_VAL_DIM, RET_CHUNK
    proj = h @ w_in
    q, k, v, g = jnp.split(proj, [H * dk, 2 * H * dk, 2 * H * dk + H * dv], axis=-1)
    q = q.reshape(B, S, H, dk).transpose(0, 2, 1, 3).astype(jnp.float32)
    k = k.reshape(B, S, H, dk).transpose(0, 2, 1, 3).astype(jnp.float32)
    v = v.reshape(B, S, H, dv).transpose(0, 2, 1, 3).astype(jnp.float32)
    pos = jnp.arange(S)
    inv_freq = jnp.power(jnp.float32(RET_ROT_BASE), -jnp.linspace(0.0, 1.0, dk // 2, dtype=jnp.float32))
    q = rotary(q, pos, dk, inv_freq)
    k = rotary(k, pos, dk, inv_freq) * (dk ** -0.5)

    log_gamma = jnp.log1p(-jnp.power(2.0, -5.0 - jnp.arange(H, dtype=jnp.float32)))
    n = jnp.arange(C, dtype=jnp.float32)
    diff = n[:, None] - n[None, :]
    tri = diff >= 0
    decay_mask = jnp.exp(jnp.where(tri[None], diff[None] * log_gamma[:, None, None], -jnp.inf))
    q_decay = jnp.exp((n[None, :] + 1.0) * log_gamma[:, None])
    k_decay = jnp.exp((C - 1.0 - n[None, :]) * log_gamma[:, None])
    chunk_decay = jnp.exp(C * log_gamma)

    nC = S // C
    def to_chunks(t):
        return t.reshape(B, H, nC, C, t.shape[-1]).transpose(2, 0, 1, 3, 4)

    def step(state, inp):
        qc, kc, vc = inp
        s = jnp.einsum('bhnd,bhmd->bhnm', qc, kc) * decay_mask[None]
        inner = jnp.einsum('bhnm,bhmv->bhnv', s, vc)
        cross = jnp.einsum('bhnd,bhdv->bhnv', qc, state) * q_decay[None, :, :, None]
        new_state = (state * chunk_decay[None, :, None, None]
                     + jnp.einsum('bhmd,bhmv->bhdv', kc * k_decay[None, :, :, None], vc))
        return new_state, inner + cross

    state0 = jnp.zeros((B, H, dk, dv), jnp.float32)
    _, out = lax.scan(step, state0, (to_chunks(q), to_chunks(k), to_chunks(v)))
    out = out.transpose(1, 0, 3, 2, 4).reshape(B, S, H, dv)
    out = out * lax.rsqrt(jnp.mean(out * out, axis=-1, keepdims=True) + RMS_EPS)
    out = out.reshape(B, S, H * dv) * gn_gain.astype(jnp.float32)
    y = (jax.nn.silu(g.astype(jnp.float32)) * out).astype(h.dtype)
    return y @ w_o


def setup_inputs(seed: int = 0) -> dict:
    key = jax.random.key(seed)
    ks = jax.random.split(key, 10)

    def w(k, shape, fan_in):
        return jax.random.normal(k, shape, jnp.float32) * (fan_in ** -0.5)

    x = jax.random.normal(ks[0], (BATCH, SEQ, D_MODEL), jnp.float32)
    norm_gain = 1.0 + 0.02 * jax.random.normal(ks[1], (DEPTH, 3, D_MODEL), jnp.float32)
    ffn_w_gate_up = w(ks[2], (DEPTH, 2, D_MODEL, 2 * FFN_DIM), D_MODEL)
    ffn_w_down = w(ks[3], (DEPTH, 2, FFN_DIM, D_MODEL), FFN_DIM)
    moba_w_qkv = w(ks[4], (N_MOBA_LAYERS, D_MODEL, 3 * MOBA_HEADS * MOBA_HEAD_DIM), D_MODEL)
    moba_w_o = w(ks[5], (N_MOBA_LAYERS, MOBA_HEADS * MOBA_HEAD_DIM, D_MODEL), MOBA_HEADS * MOBA_HEAD_DIM)
    ret_w_in = w(ks[6], (N_RET_LAYERS, D_MODEL, 2 * RET_HEADS * RET_KEY_DIM + 2 * RET_HEADS * RET_VAL_DIM), D_MODEL)
    ret_w_o = w(ks[7], (N_RET_LAYERS, RET_HEADS * RET_VAL_DIM, D_MODEL), RET_HEADS * RET_VAL_DIM)
    ret_gn_gain = 1.0 + 0.02 * jax.random.normal(ks[8], (N_RET_LAYERS, RET_HEADS * RET_VAL_DIM), jnp.float32)
    final_norm = 1.0 + 0.02 * jax.random.normal(ks[9], (D_MODEL,), jnp.float32)
    return {"x": x, "norm_gain": norm_gain, "ffn_w_gate_up": ffn_w_gate_up, "ffn_w_down": ffn_w_down,
            "moba_w_qkv": moba_w_qkv, "moba_w_o": moba_w_o, "ret_w_in": ret_w_in, "ret_w_o": ret_w_o,
            "ret_gn_gain": ret_gn_gain, "final_norm": final_norm}


def reference(x, norm_gain, ffn_w_gate_up, ffn_w_down, moba_w_qkv, moba_w_o,
              ret_w_in, ret_w_o, ret_gn_gain, final_norm):
    for i in range(DEPTH):
        g = norm_gain[i]
        x = x + FFN_RES * swiglu(rms_norm(x, g[0]), ffn_w_gate_up[i, 0], ffn_w_down[i, 0])
        h = rms_norm(x, g[1])
        j = i // N_MIXERS
        if i % N_MIXERS == 0:
            x = x + moba_attention(h, moba_w_qkv[j], moba_w_o[j])
        else:
            x = x + retention(h, ret_w_in[j], ret_w_o[j], ret_gn_gain[j])
        x = x + FFN_RES * swiglu(rms_norm(x, g[2]), ffn_w_gate_up[i, 1], ffn_w_down[i, 1])
    return rms_norm(x, final_norm)
```

```cpp
#include <hip/hip_runtime.h>
#include <hip/hip_cooperative_groups.h>
#include <cstdio>
#include <cstdint>
namespace cg = cooperative_groups;

#ifndef PH_MASK
#define PH_MASK 255
#endif
#ifndef PROBE_DUP
#define PROBE_DUP 0
#endif
#ifndef MK_ONE_LAUNCH
#define MK_ONE_LAUNCH 1
#endif

#define LAS __attribute__((address_space(3)))
#define GAS __attribute__((address_space(1)))
typedef unsigned short bf16_t;
typedef short bf16x8 __attribute__((ext_vector_type(8)));
typedef short s16x4 __attribute__((ext_vector_type(4)));
typedef float f32x4 __attribute__((ext_vector_type(4)));
typedef float f32x2 __attribute__((ext_vector_type(2)));
typedef unsigned u32x4 __attribute__((ext_vector_type(4)));
typedef unsigned u32x2 __attribute__((ext_vector_type(2)));
typedef __bf16 bf16x2_t __attribute__((ext_vector_type(2)));

constexpr int DMODEL = 2048, NBATCH = 4, SEQ = 2048, MTOK = NBATCH * SEQ, FFN = 5632;
constexpr int NQKV = 6144, NRIN = 8192;
constexpr float RMS_EPS = 1e-6f;
constexpr float LOG2E = 1.4426950408889634f;

constexpr size_t MiB = 1u << 20;
constexpr size_t WS_SS = 0;
constexpr size_t WS_KSUM = 512 * 1024;
constexpr size_t WS_BAR = 768 * 1024;
constexpr size_t WS_WGU = 1 * MiB;
constexpr size_t WS_WDN = WS_WGU + 176 * MiB;
constexpr size_t WS_WQKV = WS_WDN + 88 * MiB;
constexpr size_t WS_WMO = WS_WQKV + 24 * MiB;
constexpr size_t WS_WRIN = WS_WMO + 8 * MiB;
constexpr size_t WS_WRO = WS_WRIN + 32 * MiB;
constexpr size_t WS_XB = WS_WRO + 8 * MiB;
constexpr size_t WS_ACT = WS_XB + 32 * MiB;
constexpr size_t WS_QKV = WS_ACT + 88 * MiB;
constexpr size_t WS_AO = WS_QKV + 128 * MiB;
constexpr size_t WS_END = WS_AO + 32 * MiB;
constexpr size_t GU_ELEMS = (size_t)2 * FFN * DMODEL, DN_ELEMS = (size_t)DMODEL * FFN;

constexpr int NWAVES = 8, NTHREADS = 512;
constexpr int LDS_BYTES = 147456;

__device__ __forceinline__ unsigned cvtpk(float lo, float hi) { f32x2 v = {lo, hi}; bf16x2_t b = __builtin_convertvector(v, bf16x2_t); return __builtin_bit_cast(unsigned, b); }
__device__ __forceinline__ float bf2f(unsigned short h) { return __builtin_bit_cast(float, (unsigned)h << 16); }
__device__ __forceinline__ float silu_f(float x) { return x * __builtin_amdgcn_rcpf(1.0f + __builtin_amdgcn_exp2f(-x * LOG2E)); }
typedef unsigned long long u64;
__device__ __forceinline__ u64 ss_enc(float v) { const float fl = __builtin_floorf(v); return ((u64)(unsigned)fl << 32) | (u64)(unsigned)((v - fl) * 4294967296.0f); }
__device__ __forceinline__ float ss_dec(u64 v) { return (float)(unsigned)(v >> 32) + (float)(unsigned)v * 2.3283064365386963e-10f; }
__device__ __forceinline__ float wave_sum(float v) {
#pragma unroll
    for (int o = 1; o < 64; o <<= 1) v += __shfl_xor(v, o);
    return v;
}

namespace pg8 {
constexpr int BM = 256, BK = 64, HALF = 128, HTB = HALF * BK * 2, STAGE_BYTES = 8 * HTB, NXCD = 8, WGM = 8;
__host__ __device__ __forceinline__ int lds_byte(int r, int c) { const int st = (r >> 4) * 2 + (c >> 5), rr = r & 15, cc = c & 31, ob = rr * 64 + cc * 2; return st * 1024 + (ob ^ (((ob >> 9) & 1) << 5)); }
__host__ __device__ __forceinline__ void stage_rc(int b, int& R, int& C) { const int st = b / 1024, sb = b % 1024, swz = sb ^ (((sb >> 9) & 1) << 5); R = (st >> 1) * 16 + swz / 64; C = (st & 1) * 32 + (swz % 64) / 2; }
__host__ __device__ __forceinline__ int perm32(int rho) { const int n = rho >> 4, i = rho & 15; return 8 * (i >> 2) + 4 * n + (i & 3); }

struct Unit { int pm, pn; };
struct Gemm { const GAS bf16_t* A; const GAS bf16_t* Bt; int M, N, K; };

struct StaticOrder {
    int nM, nN, nwg, G, c;
    __host__ __device__ void init(int M, int N, int G_, int c_) { nM = M / BM; nN = N / BM; nwg = nM * nN; G = G_; c = c_; }
    __host__ __device__ bool next(int i, Unit& u) const {
        const long L = (long)i * G + c; if (L >= nwg) return false;
        int wgid = (int)L; { const int q = nwg / NXCD, r = nwg % NXCD, xcd = wgid % NXCD, off = wgid / NXCD; wgid = (xcd < r ? xcd * (q + 1) : r * (q + 1) + (xcd - r) * q) + off; }
        const int nig = WGM * nN, gid = wgid / nig, fm = gid * WGM, gsz = (nM - fm) < WGM ? (nM - fm) : WGM;
        u.pm = fm + ((wgid % nig) % gsz); u.pn = (wgid % nig) / gsz; return true;
    }
};


struct EpiGU {
    static constexpr bool PERM = true;
    GAS bf16_t* O; const GAS u64* ss;
    __device__ __forceinline__ void operator()(const f32x4 (&acc)[2][2][4][2], const Unit& u, int wr, int wc, int fr, int fq) const {
        const int row0 = u.pm * BM + wr * 64 + fr; const int col0 = u.pn * HALF + wc * 32 + 8 * fq;
        u64 ssv[8];
#pragma unroll
        for (int rg = 0; rg < 8; ++rg) ssv[rg] = ss[row0 + (rg >> 2) * HALF + (rg & 3) * 16];
#pragma unroll
        for (int ai = 0; ai < 2; ++ai)
#pragma unroll
            for (int m = 0; m < 4; ++m) {
                const int row = row0 + ai * HALF + m * 16;
                const float rs = __builtin_amdgcn_rsqf(ss_dec(ssv[ai * 4 + m]) * (1.0f / DMODEL) + RMS_EPS);
                const float rs2 = rs * rs, nrs = -rs * LOG2E;
                float v[8];
#pragma unroll
                for (int n = 0; n < 2; ++n)
#pragma unroll
                    for (int i = 0; i < 4; ++i) { const float ga = acc[ai][0][m][n][i], ua = acc[ai][1][m][n][i];
                        v[4 * n + i] = (ga * ua) * (rs2 * __builtin_amdgcn_rcpf(1.0f + __builtin_amdgcn_exp2f(ga * nrs))); }
                u32x4 w; w.x = cvtpk(v[0], v[1]); w.y = cvtpk(v[2], v[3]); w.z = cvtpk(v[4], v[5]); w.w = cvtpk(v[6], v[7]);
                __builtin_nontemporal_store(w, (GAS u32x4*)(O + (size_t)row * FFN + col0));
                asm volatile("" ::: "memory");
            }
    }
};

struct EpiRes {
    static constexpr bool PERM = true;
    GAS bf16_t* xb; GAS u64* ss_out; float scale;
    __device__ __forceinline__ void operator()(const f32x4 (&acc)[2][2][4][2], const Unit& u, int wr, int wc, int fr, int fq) const {
        const int row0 = u.pm * BM + wr * 64 + fr; const int col0 = u.pn * BM + wc * 32 + 8 * fq;
        u32x4 bc[2], bn[2];
#pragma unroll
        for (int bj = 0; bj < 2; ++bj) bc[bj] = *(const GAS u32x4*)(xb + (size_t)row0 * DMODEL + col0 + bj * HALF);
#pragma unroll
        for (int rg = 0; rg < 8; ++rg) {
            const int ai = rg >> 2, m = rg & 3;
            const int row = row0 + ai * HALF + m * 16; const size_t off = (size_t)row * DMODEL + col0;
            if (rg + 1 < 8) {
                const size_t offn = (size_t)(row0 + ((rg + 1) >> 2) * HALF + ((rg + 1) & 3) * 16) * DMODEL + col0;
#pragma unroll
                for (int bj = 0; bj < 2; ++bj) bn[bj] = *(const GAS u32x4*)(xb + offn + bj * HALF);
            }
            asm volatile("" ::: "memory");
            float s2 = 0.f;
#pragma unroll
            for (int bj = 0; bj < 2; ++bj) {
                const u32x4 bb = bc[bj];
                unsigned wv[4];
#pragma unroll
                for (int n = 0; n < 2; ++n) {
                    const unsigned b0 = bb[2 * n], b1 = bb[2 * n + 1];
                    const f32x4 bf = (f32x4){__builtin_bit_cast(float, b0 << 16), __builtin_bit_cast(float, b0 & 0xffff0000u), __builtin_bit_cast(float, b1 << 16), __builtin_bit_cast(float, b1 & 0xffff0000u)};
                    const f32x4 o = bf + acc[ai][bj][m][n] * scale;
                    wv[2 * n] = cvtpk(o[0], o[1]); wv[2 * n + 1] = cvtpk(o[2], o[3]);
                    s2 += (o[0] * o[0] + o[1] * o[1]) + (o[2] * o[2] + o[3] * o[3]);
                }
                *(GAS u32x4*)(xb + off + bj * HALF) = (u32x4){wv[0], wv[1], wv[2], wv[3]};
            }
            s2 += __shfl_xor(s2, 16); s2 += __shfl_xor(s2, 32);
            if (fq == 0) __hip_atomic_fetch_add(ss_out + row, ss_enc(s2), __ATOMIC_RELAXED, __HIP_MEMORY_SCOPE_AGENT);
            asm volatile("" ::: "memory");
#pragma unroll
            for (int bj = 0; bj < 2; ++bj) bc[bj] = bn[bj];
        }
    }
};

struct EpiQKV {
    static constexpr bool PERM = false;
    GAS bf16_t* O; const GAS u64* ss; GAS float* ksum;
    __device__ __forceinline__ void operator()(const f32x4 (&acc)[2][2][4][2], const Unit& u, int wr, int wc, int fr, int fq) const {
        const int row0 = u.pm * BM + wr * 64 + fr; const int col0 = u.pn * BM + wc * 32 + 4 * fq;
        const int t = u.pn >> 3;
        const bool rot = (t < 2) && (wc == 0);
        const float qs = (t == 0) ? (0.08838834764831845f * LOG2E) : 1.0f;
        float invf[4];
#pragma unroll
        for (int i = 0; i < 4; ++i) invf[i] = __builtin_amdgcn_exp2f(-(float)(4 * fq + i) * (18.931568569324174f / 16.0f)) * 0.15915494309189535f;
        f32x4 csum[2][2];
#pragma unroll
        for (int bj = 0; bj < 2; ++bj)
#pragma unroll
            for (int n = 0; n < 2; ++n) csum[bj][n] = (f32x4){0.f, 0.f, 0.f, 0.f};
        u64 ssv[8];
#pragma unroll
        for (int rg = 0; rg < 8; ++rg) ssv[rg] = ss[row0 + (rg >> 2) * HALF + (rg & 3) * 16];
#pragma unroll
        for (int ai = 0; ai < 2; ++ai)
#pragma unroll
            for (int m = 0; m < 4; ++m) {
                const int row = row0 + ai * HALF + m * 16;
                const float rs = __builtin_amdgcn_rsqf(ss_dec(ssv[ai * 4 + m]) * (1.0f / DMODEL) + RMS_EPS);
                const float pos = (float)(row & (SEQ - 1));
#pragma unroll
                for (int bj = 0; bj < 2; ++bj) {
                    f32x4 v0 = acc[ai][bj][m][0] * rs, v1 = acc[ai][bj][m][1] * rs;
                    if (rot) {
#pragma unroll
                        for (int i = 0; i < 4; ++i) {
                            float rev = pos * invf[i]; rev = rev - __builtin_floorf(rev);
                            const float c = __builtin_amdgcn_cosf(rev), s = __builtin_amdgcn_sinf(rev);
                            const float a = v0[i], b = v1[i];
                            v0[i] = a * c - b * s; v1[i] = a * s + b * c;
                        }
                    }
                    if (t == 1) { csum[bj][0] += v0; csum[bj][1] += v1; }
                    v0 = v0 * qs; v1 = v1 * qs;
                    u32x2 w0, w1; w0.x = cvtpk(v0[0], v0[1]); w0.y = cvtpk(v0[2], v0[3]); w1.x = cvtpk(v1[0], v1[1]); w1.y = cvtpk(v1[2], v1[3]);
                    GAS bf16_t* p = O + (size_t)row * NQKV + col0 + bj * HALF;
                    *(GAS u32x2*)(p) = w0; *(GAS u32x2*)(p + 16) = w1;
                }
                asm volatile("" ::: "memory");
            }
        if (t == 1) {
#pragma unroll
            for (int bj = 0; bj < 2; ++bj)
#pragma unroll
                for (int n = 0; n < 2; ++n)
#pragma unroll
                    for (int i = 0; i < 4; ++i) {
                        float v = csum[bj][n][i];
                        v += __shfl_xor(v, 1); v += __shfl_xor(v, 2); v += __shfl_xor(v, 4); v += __shfl_xor(v, 8);
                        if (fr == 0) __hip_atomic_fetch_add(ksum + (size_t)u.pm * DMODEL + (u.pn - 8) * BM + bj * HALF + wc * 32 + n * 16 + 4 * fq + i, v, __ATOMIC_RELAXED, __HIP_MEMORY_SCOPE_AGENT);
                    }
        }
    }
};

struct EpiRIN {
    static constexpr bool PERM = true;
    GAS bf16_t* O; const GAS u64* ss;
    __device__ __forceinline__ void operator()(const f32x4 (&acc)[2][2][4][2], const Unit& u, int wr, int wc, int fr, int fq) const {
        const int row0 = u.pm * BM + wr * 64 + fr; const int col0 = u.pn * BM + wc * 32 + 8 * fq;
        const int t = u.pn >> 3;
        const float ks = (t == 1) ? 0.0625f : 1.0f;
        float invf[2][4];
#pragma unroll
        for (int n = 0; n < 2; ++n)
#pragma unroll
            for (int i = 0; i < 4; ++i) invf[n][i] = __builtin_amdgcn_exp2f(-(float)(wc * 32 + 8 * fq + 4 * n + i) * (13.287712379549449f / 127.0f)) * 0.15915494309189535f;
        u64 ssv[8];
#pragma unroll
        for (int rg = 0; rg < 8; ++rg) ssv[rg] = ss[row0 + (rg >> 2) * HALF + (rg & 3) * 16];
#pragma unroll
        for (int ai = 0; ai < 2; ++ai)
#pragma unroll
            for (int m = 0; m < 4; ++m) {
                const int row = row0 + ai * HALF + m * 16;
                const float rs = __builtin_amdgcn_rsqf(ss_dec(ssv[ai * 4 + m]) * (1.0f / DMODEL) + RMS_EPS);
                const float pos = (float)(row & (SEQ - 1));
                float v[2][8];
#pragma unroll
                for (int n = 0; n < 2; ++n)
#pragma unroll
                    for (int i = 0; i < 4; ++i) {
                        float a = acc[ai][0][m][n][i] * rs, b = acc[ai][1][m][n][i] * rs;
                        if (t < 2) {
                            float rev = pos * invf[n][i]; rev = rev - __builtin_floorf(rev);
                            const float c = __builtin_amdgcn_cosf(rev), s = __builtin_amdgcn_sinf(rev);
                            const float a2 = a * c - b * s, b2 = a * s + b * c; a = a2 * ks; b = b2 * ks;
                        } else if (t == 3) { a = silu_f(a); b = silu_f(b); }
                        v[0][4 * n + i] = a; v[1][4 * n + i] = b;
                    }
#pragma unroll
                for (int bj = 0; bj < 2; ++bj) {
                    u32x4 w; w.x = cvtpk(v[bj][0], v[bj][1]); w.y = cvtpk(v[bj][2], v[bj][3]); w.z = cvtpk(v[bj][4], v[bj][5]); w.w = cvtpk(v[bj][6], v[bj][7]);
                    *(GAS u32x4*)(O + (size_t)row * NRIN + col0 + bj * HALF) = w;
                }
                asm volatile("" ::: "memory");
            }
    }
};

template <class Epi, class Sched, bool ALIGN_EPI = false, bool SP2 = false>
__device__ __forceinline__ void gemm_phase(LAS unsigned char* lds, const Gemm g, const Sched& S, const Epi& E, const int tid) {
    const int wid = __builtin_amdgcn_readfirstlane(tid >> 6), lane = tid & 63, wr = wid >> 2, wc = wid & 3, fr = lane & 15, fq = lane >> 4;
    const int K = g.K, nt = K / BK;
    unsigned voffA[2], voffB[2];
#pragma unroll
    for (int i = 0; i < 2; ++i) { int R, C; stage_rc(tid * 16 + i * 8192, R, C); const int Rb = Epi::PERM ? ((R & ~31) + perm32(R & 31)) : R;
        voffA[i] = (unsigned)(R * K + C) * 2u; voffB[i] = (unsigned)(Rb * K + C) * 2u; }
    const size_t kstep = (size_t)(BK * 2);
    const size_t hstep = (size_t)HALF * K * 2;
    const size_t tstep = 2 * hstep;
    const unsigned ldsw = (unsigned)wid * 1024u;
    const int aoff = lds_byte(wr * 64 + fr, fq * 8), boff = lds_byte(wc * 32 + fr, fq * 8);
#define PG8_SA(b, h) (((b) * 2 + (h)) * HTB)
#define PG8_SB(b, h) ((4 + (b) * 2 + (h)) * HTB)
#define PG8_STAGE(bufoff, gbase, voff) do { _Pragma("unroll") for (int _i = 0; _i < 2; ++_i) \
        __builtin_amdgcn_global_load_lds((const unsigned*)((const GAS char*)(gbase) + (voff)[_i]), (LAS unsigned*)(lds + (bufoff) + ldsw + _i * 8192), 16, 0, 0); } while (0)
#define PG8_LDA(dst, b, h) do { _Pragma("unroll") for (int m = 0; m < 4; ++m) _Pragma("unroll") for (int k = 0; k < 2; ++k) dst[m][k] = *(const LAS bf16x8*)(lds + PG8_SA(b, h) + aoff + m * 2048 + k * 1024); } while (0)
#define PG8_LDB(dst, b, h) do { _Pragma("unroll") for (int n = 0; n < 2; ++n) _Pragma("unroll") for (int k = 0; k < 2; ++k) dst[n][k] = *(const LAS bf16x8*)(lds + PG8_SB(b, h) + boff + n * 2048 + k * 1024); } while (0)
#define PG8_MMA(ai, bj, At, Bt) do { __builtin_amdgcn_s_setprio(1); _Pragma("unroll") for (int k = 0; k < 2; ++k) _Pragma("unroll") for (int m = 0; m < 4; ++m) _Pragma("unroll") for (int n = 0; n < 2; ++n) \
        acc[ai][bj][m][n] = __builtin_amdgcn_mfma_f32_16x16x32_bf16(Bt[n][k], At[m][k], acc[ai][bj][m][n], 0, 0, 0); __builtin_amdgcn_s_setprio(0); } while (0)
#define PG8_WAIT_V(n) asm volatile("s_waitcnt vmcnt(" #n ")" ::: "memory")
#define PG8_WAIT_L(n) asm volatile("s_waitcnt lgkmcnt(" #n ")" ::: "memory")
#define PG8_BAR __builtin_amdgcn_s_barrier()
#define PG8_SCHED __builtin_amdgcn_sched_barrier(0)
    Unit cur, nxt; int ui = 0;
    if (!S.next(0, cur)) return;
    f32x4 acc[2][2][4][2];
#pragma unroll
    for (int a = 0; a < 2; ++a)
#pragma unroll
        for (int b = 0; b < 2; ++b)
#pragma unroll
            for (int m = 0; m < 4; ++m)
#pragma unroll
                for (int n = 0; n < 2; ++n) acc[a][b][m][n] = (f32x4){0.f, 0.f, 0.f, 0.f};
    bf16x8 At[4][2], B0[2][2], B1[2][2];
    const GAS char* cA = (const GAS char*)g.A + (size_t)cur.pm * tstep; const GAS char* cB = (const GAS char*)g.Bt + (size_t)cur.pn * tstep;
    if constexpr (SP2) {
        PG8_STAGE(PG8_SB(0, 0), cB, voffB); PG8_STAGE(PG8_SB(0, 1), cB + hstep, voffB); PG8_STAGE(PG8_SA(0, 0), cA, voffA); PG8_STAGE(PG8_SA(0, 1), cA + hstep, voffA);
        if (wr == 1) PG8_BAR;
        PG8_WAIT_V(2); PG8_BAR;
        PG8_STAGE(PG8_SB(1, 0), cB + kstep, voffB); PG8_STAGE(PG8_SA(1, 0), cA + kstep, voffA); PG8_STAGE(PG8_SB(1, 1), cB + hstep + kstep, voffB);
        PG8_WAIT_V(6); PG8_BAR;
    } else {
        PG8_STAGE(PG8_SB(0, 0), cB, voffB); PG8_STAGE(PG8_SA(0, 0), cA, voffA); PG8_STAGE(PG8_SB(0, 1), cB + hstep, voffB); PG8_STAGE(PG8_SA(0, 1), cA + hstep, voffA);
        if (wr == 1) PG8_BAR;
        PG8_WAIT_V(4); PG8_BAR;
        PG8_STAGE(PG8_SB(1, 0), cB + kstep, voffB); PG8_STAGE(PG8_SA(1, 0), cA + kstep, voffA); PG8_STAGE(PG8_SB(1, 1), cB + hstep + kstep, voffB);
        PG8_WAIT_V(6); PG8_BAR;
    }
    for (;;) {
        const bool has_next = S.next(ui + 1, nxt);
        const GAS char* nA = has_next ? (const GAS char*)g.A + (size_t)nxt.pm * tstep : cA; const GAS char* nB = has_next ? (const GAS char*)g.Bt + (size_t)nxt.pn * tstep : cB;
        for (int t = 0; t < nt; t += 2) {
            const bool last = (t == nt - 2);
            const GAS char* a1 = cA + (size_t)(t + 1) * kstep;
            const GAS char* a2 = last ? nA : cA + (size_t)(t + 2) * kstep; const GAS char* b2 = last ? nB : cB + (size_t)(t + 2) * kstep;
            const GAS char* a3 = a2 + kstep; const GAS char* b3 = b2 + kstep;
            if constexpr (SP2) {
            PG8_LDB(B0, 0, 0); PG8_LDB(B1, 0, 1); PG8_SCHED; PG8_LDA(At, 0, 0); PG8_STAGE(PG8_SA(1, 1), a1 + hstep, voffA);
            PG8_WAIT_V(8); PG8_WAIT_L(0); PG8_BAR; PG8_MMA(0, 0, At, B0); PG8_MMA(0, 1, At, B1); PG8_BAR; PG8_SCHED;
            PG8_LDA(At, 0, 1); PG8_STAGE(PG8_SB(0, 0), b2, voffB); PG8_STAGE(PG8_SB(0, 1), b2 + hstep, voffB); PG8_STAGE(PG8_SA(0, 0), a2, voffA);
            PG8_WAIT_V(8); PG8_WAIT_L(0); PG8_BAR; PG8_MMA(1, 0, At, B0); PG8_MMA(1, 1, At, B1); PG8_BAR; PG8_SCHED;
            PG8_LDB(B0, 1, 0); PG8_LDB(B1, 1, 1); PG8_SCHED; PG8_LDA(At, 1, 0); PG8_STAGE(PG8_SA(0, 1), a2 + hstep, voffA);
            PG8_WAIT_V(8); PG8_WAIT_L(0); PG8_BAR; PG8_MMA(0, 0, At, B0); PG8_MMA(0, 1, At, B1); PG8_BAR; PG8_SCHED;
            PG8_LDA(At, 1, 1); PG8_STAGE(PG8_SB(1, 0), b3, voffB); PG8_STAGE(PG8_SB(1, 1), b3 + hstep, voffB); PG8_STAGE(PG8_SA(1, 0), a3, voffA);
            PG8_WAIT_V(8); PG8_WAIT_L(0); PG8_BAR; PG8_MMA(1, 0, At, B0); PG8_MMA(1, 1, At, B1); PG8_BAR; PG8_SCHED;
            } else {
            PG8_LDB(B0, 0, 0); PG8_SCHED; PG8_LDA(At, 0, 0); PG8_STAGE(PG8_SA(1, 1), a1 + hstep, voffA);
            PG8_WAIT_L(8); PG8_BAR; PG8_WAIT_L(0); PG8_MMA(0, 0, At, B0); PG8_BAR; PG8_SCHED;
            PG8_LDB(B1, 0, 1); PG8_STAGE(PG8_SB(0, 0), b2, voffB);
            PG8_BAR; PG8_WAIT_L(0); PG8_MMA(0, 1, At, B1); PG8_BAR;
            PG8_LDA(At, 0, 1); PG8_STAGE(PG8_SA(0, 0), a2, voffA);
            PG8_BAR; PG8_WAIT_L(0); PG8_MMA(1, 0, At, B0); PG8_BAR; PG8_SCHED;
            PG8_STAGE(PG8_SB(0, 1), b2 + hstep, voffB);
            PG8_WAIT_V(6); PG8_BAR; PG8_MMA(1, 1, At, B1); PG8_BAR;
            PG8_LDB(B0, 1, 0); PG8_SCHED; PG8_LDA(At, 1, 0); PG8_STAGE(PG8_SA(0, 1), a2 + hstep, voffA);
            PG8_WAIT_L(8); PG8_BAR; PG8_WAIT_L(0); PG8_MMA(0, 0, At, B0); PG8_BAR; PG8_SCHED;
            PG8_LDB(B1, 1, 1); PG8_STAGE(PG8_SB(1, 0), b3, voffB);
            PG8_BAR; PG8_WAIT_L(0); PG8_MMA(0, 1, At, B1); PG8_BAR;
            PG8_LDA(At, 1, 1); PG8_STAGE(PG8_SA(1, 0), a3, voffA);
            PG8_BAR; PG8_WAIT_L(0); PG8_MMA(1, 0, At, B0); PG8_BAR; PG8_SCHED;
            PG8_STAGE(PG8_SB(1, 1), b3 + hstep, voffB);
            PG8_WAIT_V(6); PG8_BAR; PG8_MMA(1, 1, At, B1); PG8_BAR;
            }
        }
        if constexpr (ALIGN_EPI) { if (wr == 0) PG8_BAR; }
        E(acc, cur, wr, wc, fr, fq);
        if (!has_next) break;
#pragma unroll
        for (int a = 0; a < 2; ++a)
#pragma unroll
            for (int b = 0; b < 2; ++b)
#pragma unroll
                for (int m = 0; m < 4; ++m)
#pragma unroll
                    for (int n = 0; n < 2; ++n) acc[a][b][m][n] = (f32x4){0.f, 0.f, 0.f, 0.f};
        cur = nxt; cA = nA; cB = nB; ++ui;
        if constexpr (ALIGN_EPI) { if (wr == 1) PG8_BAR; }
    }
    PG8_WAIT_V(0);
    if constexpr (!ALIGN_EPI) { if (wr == 0) PG8_BAR; }
    PG8_BAR;
#undef PG8_SA
#undef PG8_SB
#undef PG8_STAGE
#undef PG8_LDA
#undef PG8_LDB
#undef PG8_MMA
#undef PG8_WAIT_V
#undef PG8_WAIT_L
#undef PG8_BAR
#undef PG8_SCHED
}
}

template <int DK, int DV, bool MOBA>
__device__ __forceinline__ void attn_unit(LAS unsigned char* lds, const GAS bf16_t* Qb, const GAS bf16_t* Kb, const GAS bf16_t* Vb, int ld, int q0, GAS bf16_t* Out,
                                          const GAS float* ksum  , float lg2  ,
                                          const GAS bf16_t* SGb  , const GAS float* gn  , const int tid) {
    constexpr int KRS = DK * 2 + 16, VRS = DV * 2 + 32;
    constexpr int OFF_K = 0, OFF_V = 2 * 64 * KRS, OFF_MISC = OFF_V + 2 * 64 * VRS;
    constexpr int KCPR = DK / 8, KCH = 64 * KCPR / NTHREADS, VCPR = DV / 8, VCH = 64 * VCPR / NTHREADS;
    static_assert(OFF_MISC + 4096 <= LDS_BYTES, "attention LDS");
    int tl = tid; asm volatile("" : "+v"(tl));
    const int lane = tl & 63, w = __builtin_amdgcn_readfirstlane(tl >> 6), lq = lane & 15, g = lane >> 4;
    const int qpos = q0 + 16 * w + lq;
    const int qb = q0 >> 8;
    unsigned selmask = 0;
    int ntown, nt;
    if constexpr (MOBA) {
        LAS float* km = (LAS float*)(lds + OFF_MISC);
        for (int idx = tid; idx < qb * 128; idx += NTHREADS) km[idx] = ksum[(size_t)(idx >> 7) * DMODEL + (idx & 127)];
        __syncthreads();
        float g0 = 0.f, g1 = 0.f;
        const GAS bf16_t* qrow = Qb + (size_t)qpos * ld;
#pragma unroll 4
        for (int c = 0; c < 16; ++c) {
            const u32x4 qq = *(const GAS u32x4*)(qrow + 8 * c);
#pragma unroll
            for (int e = 0; e < 4; ++e) {
                const float lo = __builtin_bit_cast(float, qq[e] << 16), hi = __builtin_bit_cast(float, qq[e] & 0xffff0000u);
                g0 += lo * km[g * 128 + 8 * c + 2 * e] + hi * km[g * 128 + 8 * c + 2 * e + 1];
                g1 += lo * km[(g + 4) * 128 + 8 * c + 2 * e] + hi * km[(g + 4) * 128 + 8 * c + 2 * e + 1];
            }
        }
        float gt[8];
#pragma unroll
        for (int j = 0; j < 8; ++j) gt[j] = __shfl(j < 4 ? g0 : g1, lq + 16 * (j & 3));
#pragma unroll
        for (int j = 0; j < 8; ++j) {
            int cnt = 0;
#pragma unroll
            for (int j2 = 0; j2 < 8; ++j2) if (j2 != j) cnt += (j2 < qb && (gt[j2] > gt[j] || (gt[j2] == gt[j] && j2 < j))) ? 1 : 0;
            if (j < qb && cnt < 3) selmask |= 1u << j;
        }
        ntown = ((q0 & 255) + 128) >> 6;
        nt = ntown + 4 * qb;
    } else {
        ntown = 0; nt = (q0 + 128) >> 6;
    }
    bf16x8 qf[DK / 32];
    {
        const GAS bf16_t* qrow = Qb + (size_t)qpos * ld + 8 * g;
#pragma unroll
        for (int ks = 0; ks < DK / 32; ++ks) qf[ks] = *(const GAS bf16x8*)(qrow + 32 * ks);
    }
    f32x4 o[DV / 16];
#pragma unroll
    for (int dt = 0; dt < DV / 16; ++dt) o[dt] = (f32x4){0.f, 0.f, 0.f, 0.f};
    float mrow = -1e30f, lsum = 0.f;
    float dc1[4], dc2[4];
#pragma unroll
    for (int i = 0; i < 4; ++i) {
        dc1[i] = MOBA ? 1.f : __builtin_bit_cast(float, __builtin_amdgcn_readfirstlane(__builtin_bit_cast(int, __builtin_amdgcn_exp2f(-lg2 * (float)(16 * i)))));
        dc2[i] = MOBA ? 1.f : __builtin_bit_cast(float, __builtin_amdgcn_readfirstlane(__builtin_bit_cast(int, __builtin_amdgcn_exp2f(-lg2 * (float)i))));
    }
    u32x4 kreg[KCH], vreg[VCH];
#define ATT_KEY0(ti) (MOBA ? ((ti) < ntown ? (qb * 256 + 64 * (ti)) : 64 * ((ti) - ntown)) : 64 * (ti))
#define ATT_GLOADK(key0) do { int tq = tid; asm volatile("" : "+v"(tq)); \
        _Pragma("unroll") for (int j = 0; j < KCH; ++j) { const unsigned cidx = (unsigned)tq + NTHREADS * j; kreg[j] = *(const GAS u32x4*)(Kb + (size_t)((key0) + cidx / KCPR) * ld + (cidx % KCPR) * 8); } } while (0)
#define ATT_GLOADV(key0) do { int tq = tid; asm volatile("" : "+v"(tq)); \
        _Pragma("unroll") for (int j = 0; j < VCH; ++j) { const unsigned cidx = (unsigned)tq + NTHREADS * j; vreg[j] = *(const GAS u32x4*)(Vb + (size_t)((key0) + cidx / VCPR) * ld + (cidx % VCPR) * 8); } } while (0)
#define ATT_LWRITEK(buf) do { int tq = tid; asm volatile("" : "+v"(tq)); \
        _Pragma("unroll") for (int j = 0; j < KCH; ++j) { const unsigned cidx = (unsigned)tq + NTHREADS * j; *(LAS u32x4*)(lds + OFF_K + (buf) * 64 * KRS + (cidx / KCPR) * KRS + (cidx % KCPR) * 16) = kreg[j]; } } while (0)
#define ATT_LWRITEV(buf) do { int tq = tid; asm volatile("" : "+v"(tq)); \
        _Pragma("unroll") for (int j = 0; j < VCH; ++j) { const unsigned cidx = (unsigned)tq + NTHREADS * j; *(LAS u32x4*)(lds + OFF_V + (buf) * 64 * VRS + (cidx / VCPR) * VRS + (cidx % VCPR) * 16) = vreg[j]; } } while (0)
    ATT_GLOADK(ATT_KEY0(0));
    ATT_LWRITEK(0);
    ATT_GLOADV(ATT_KEY0(0));
    ATT_LWRITEV(0);
    __syncthreads();
    for (int ti = 0; ti < nt; ++ti) {
        const int buf = ti & 1;
        const int key0 = ATT_KEY0(ti);
        const int nk0 = ATT_KEY0(ti + 1);
        if (ti + 1 < nt) { ATT_GLOADK(nk0); ATT_GLOADV(nk0); }
        bool active;
        const bool diag = MOBA ? (ti < ntown) : (key0 + 63 > q0);
        if constexpr (MOBA) {
            if (ti < ntown) active = (key0 <= q0 + 16 * w + 15);
            else active = __any((selmask >> ((ti - ntown) >> 2)) & 1u) != 0;
        } else active = (key0 <= q0 + 16 * w + 15);
        if (active) {
            f32x4 s[4];
#pragma unroll
            for (int kt = 0; kt < 4; ++kt) s[kt] = (f32x4){0.f, 0.f, 0.f, 0.f};
            const LAS unsigned char* kbase = lds + OFF_K + buf * 64 * KRS + lq * KRS + g * 16;
            bf16x8 kfa[4], kfb[4];
#pragma unroll
            for (int kt = 0; kt < 4; ++kt) kfa[kt] = *(const LAS bf16x8*)(kbase + kt * 16 * KRS);
#pragma unroll
            for (int ks = 0; ks < DK / 32; ks += 2) {
#pragma unroll
                for (int kt = 0; kt < 4; ++kt) kfb[kt] = *(const LAS bf16x8*)(kbase + kt * 16 * KRS + (ks + 1) * 64);
#pragma unroll
                for (int kt = 0; kt < 4; ++kt) s[kt] = __builtin_amdgcn_mfma_f32_16x16x32_bf16(kfa[kt], qf[ks], s[kt], 0, 0, 0);
                __builtin_amdgcn_sched_barrier(0);
                if (ks + 2 < DK / 32) {
#pragma unroll
                    for (int kt = 0; kt < 4; ++kt) kfa[kt] = *(const LAS bf16x8*)(kbase + kt * 16 * KRS + (ks + 2) * 64);
                }
#pragma unroll
                for (int kt = 0; kt < 4; ++kt) s[kt] = __builtin_amdgcn_mfma_f32_16x16x32_bf16(kfb[kt], qf[ks + 1], s[kt], 0, 0, 0);
                __builtin_amdgcn_sched_barrier(0);
            }
            unsigned pk[4][2];
            if constexpr (MOBA) {
                const float NEG = -INFINITY;
                if (diag) {
#pragma unroll
                    for (int kt = 0; kt < 4; ++kt)
#pragma unroll
                        for (int r = 0; r < 4; ++r) if (key0 + 16 * kt + 4 * g + r > qpos) s[kt][r] = NEG;
                } else if (!((selmask >> ((ti - ntown) >> 2)) & 1u)) {
#pragma unroll
                    for (int kt = 0; kt < 4; ++kt) s[kt] = (f32x4){NEG, NEG, NEG, NEG};
                }
                float mx = NEG;
#pragma unroll
                for (int kt = 0; kt < 4; ++kt) mx = fmaxf(mx, fmaxf(fmaxf(s[kt][0], s[kt][1]), fmaxf(s[kt][2], s[kt][3])));
                mx = fmaxf(mx, __shfl_xor(mx, 16)); mx = fmaxf(mx, __shfl_xor(mx, 32));
                const float mnew = fmaxf(mrow, mx);
                const float alpha = __builtin_amdgcn_exp2f(mrow - mnew);
                mrow = mnew;
                float ps = 0.f;
#pragma unroll
                for (int kt = 0; kt < 4; ++kt) {
#pragma unroll
                    for (int r = 0; r < 4; ++r) { s[kt][r] = __builtin_amdgcn_exp2f(s[kt][r] - mnew); ps += s[kt][r]; }
                    pk[kt][0] = cvtpk(s[kt][0], s[kt][1]); pk[kt][1] = cvtpk(s[kt][2], s[kt][3]);
                }
                lsum = lsum * alpha + ps;
#pragma unroll
                for (int dt = 0; dt < DV / 16; ++dt) o[dt] = o[dt] * alpha;
            } else if (diag) {
#pragma unroll
                for (int kt = 0; kt < 4; ++kt) {
#pragma unroll
                    for (int r = 0; r < 4; ++r) {
                        const int dist = qpos - (key0 + 16 * kt + 4 * g + r);
                        const float dec = __builtin_amdgcn_exp2f((float)dist * lg2);
                        s[kt][r] = (dist >= 0) ? s[kt][r] * dec : 0.f;
                    }
                    pk[kt][0] = cvtpk(s[kt][0], s[kt][1]); pk[kt][1] = cvtpk(s[kt][2], s[kt][3]);
                }
            } else {
                const float rowf = __builtin_amdgcn_exp2f((float)(qpos - key0 - 4 * g) * lg2);
#pragma unroll
                for (int kt = 0; kt < 4; ++kt) {
                    const float rk = rowf * dc1[kt];
#pragma unroll
                    for (int r = 0; r < 4; ++r) s[kt][r] = s[kt][r] * (rk * dc2[r]);
                    pk[kt][0] = cvtpk(s[kt][0], s[kt][1]); pk[kt][1] = cvtpk(s[kt][2], s[kt][3]);
                }
            }
            const LAS unsigned char* vbase = lds + OFF_V + buf * 64 * VRS + (4 * g + (lq >> 2)) * VRS + (lane & 3) * 8;
            {
                constexpr int GPS = DV / 64, NG = 2 * GPS;
                bf16x8 pf[2];
#pragma unroll
                for (int s2 = 0; s2 < 2; ++s2) { const u32x4 pw = (u32x4){pk[2 * s2][0], pk[2 * s2][1], pk[2 * s2 + 1][0], pk[2 * s2 + 1][1]}; pf[s2] = __builtin_bit_cast(bf16x8, pw); }
                bf16x8 vfa[4], vfb[4];
#define ATT_LOADV(dst, gi) do { _Pragma("unroll") for (int j = 0; j < 4; ++j) { const int dt_ = ((gi) % GPS) * 4 + j; \
                    const s16x4 v0 = __builtin_amdgcn_ds_read_tr16_b64_v4i16((LAS s16x4*)(vbase + (32 * ((gi) / GPS)) * VRS + dt_ * 32)); \
                    const s16x4 v1 = __builtin_amdgcn_ds_read_tr16_b64_v4i16((LAS s16x4*)(vbase + (32 * ((gi) / GPS) + 16) * VRS + dt_ * 32)); \
                    dst[j] = (bf16x8){v0[0], v0[1], v0[2], v0[3], v1[0], v1[1], v1[2], v1[3]}; } } while (0)
#define ATT_MMAV(src, gi) do { _Pragma("unroll") for (int j = 0; j < 4; ++j) { const int dt_ = ((gi) % GPS) * 4 + j; o[dt_] = __builtin_amdgcn_mfma_f32_16x16x32_bf16(src[j], pf[(gi) / GPS], o[dt_], 0, 0, 0); } } while (0)
                ATT_LOADV(vfa, 0);
#pragma unroll
                for (int gi = 0; gi < NG; gi += 2) {
                    ATT_LOADV(vfb, gi + 1);
                    ATT_MMAV(vfa, gi);
                    __builtin_amdgcn_sched_barrier(0);
                    if (gi + 2 < NG) ATT_LOADV(vfa, gi + 2);
                    ATT_MMAV(vfb, gi + 1);
                    __builtin_amdgcn_sched_barrier(0);
                }
#undef ATT_LOADV
#undef ATT_MMAV
            }
        }
        if (ti + 1 < nt) { ATT_LWRITEK(buf ^ 1); ATT_LWRITEV(buf ^ 1); }
        __syncthreads();
    }
#undef ATT_KEY0
#undef ATT_GLOADK
#undef ATT_GLOADV
#undef ATT_LWRITEK
#undef ATT_LWRITEV
    int te = tid; asm volatile("" : "+v"(te));
    const int g_e = (te & 63) >> 4, qpos_e = q0 + 16 * (te >> 6) + (te & 15);
    if constexpr (MOBA) {
        float l = lsum; l += __shfl_xor(l, 16); l += __shfl_xor(l, 32);
        const float inv = __builtin_amdgcn_rcpf(l);
        GAS bf16_t* orow = Out + (size_t)qpos_e * DMODEL + 4 * g_e;
#pragma unroll
        for (int dt = 0; dt < DV / 16; ++dt) { u32x2 wv; wv.x = cvtpk(o[dt][0] * inv, o[dt][1] * inv); wv.y = cvtpk(o[dt][2] * inv, o[dt][3] * inv); *(GAS u32x2*)(orow + 16 * dt) = wv; }
    } else {
        float s2 = 0.f;
#pragma unroll
        for (int dt = 0; dt < DV / 16; ++dt) s2 += (o[dt][0] * o[dt][0] + o[dt][1] * o[dt][1]) + (o[dt][2] * o[dt][2] + o[dt][3] * o[dt][3]);
        s2 += __shfl_xor(s2, 16); s2 += __shfl_xor(s2, 32);
        const float rs = __builtin_amdgcn_rsqf(s2 * (1.0f / DV) + RMS_EPS);
        GAS bf16_t* orow = Out + (size_t)qpos_e * DMODEL + 4 * g_e;
        const GAS bf16_t* sgrow = SGb + (size_t)qpos_e * ld + 4 * g_e;
#pragma unroll
        for (int dt = 0; dt < DV / 16; ++dt) {
            const u32x2 sg = *(const GAS u32x2*)(sgrow + 16 * dt);
            const f32x4 gg = *(const GAS f32x4*)(gn + 16 * dt + 4 * g_e);
            const float y0 = o[dt][0] * rs * gg[0] * __builtin_bit_cast(float, sg.x << 16), y1 = o[dt][1] * rs * gg[1] * __builtin_bit_cast(float, sg.x & 0xffff0000u);
            const float y2 = o[dt][2] * rs * gg[2] * __builtin_bit_cast(float, sg.y << 16), y3 = o[dt][3] * rs * gg[3] * __builtin_bit_cast(float, sg.y & 0xffff0000u);
            u32x2 wv; wv.x = cvtpk(y0, y1); wv.y = cvtpk(y2, y3); *(GAS u32x2*)(orow + 16 * dt) = wv;
        }
    }
}

__device__ __forceinline__ void moba_unit256(LAS unsigned char* lds, const GAS bf16_t* Qb, const GAS bf16_t* Kb, const GAS bf16_t* Vb, const int qb, GAS bf16_t* Out, const GAS float* ksum, const int tid) {
    constexpr int DK = 128, DV = 128, ld = NQKV;
    constexpr int KRS = DK * 2 + 16, VRS = DV * 2 + 32;
    constexpr int OFF_K = 0, OFF_V = 2 * 64 * KRS, OFF_MISC = OFF_V + 2 * 64 * VRS;
    constexpr int KCPR = DK / 8, KCH = 64 * KCPR / NTHREADS, VCPR = DV / 8, VCH = 64 * VCPR / NTHREADS;
    int tl = tid; asm volatile("" : "+v"(tl));
    const int lane = tl & 63, w = __builtin_amdgcn_readfirstlane(tl >> 6), lq = lane & 15, g = lane >> 4;
    const int q0 = qb * 256;
    int qpos[2]; qpos[0] = q0 + 32 * w + lq; qpos[1] = qpos[0] + 16;
    unsigned selmask[2] = {0u, 0u};
    {
        LAS float* km = (LAS float*)(lds + OFF_MISC);
        for (int idx = tid; idx < qb * 128; idx += NTHREADS) km[idx] = ksum[(size_t)(idx >> 7) * DMODEL + (idx & 127)];
        __syncthreads();
#pragma unroll
        for (int st = 0; st < 2; ++st) {
            float g0 = 0.f, g1 = 0.f;
            const GAS bf16_t* qrow = Qb + (size_t)qpos[st] * ld;
#pragma unroll 4
            for (int c = 0; c < 16; ++c) {
                const u32x4 qq = *(const GAS u32x4*)(qrow + 8 * c);
#pragma unroll
                for (int e = 0; e < 4; ++e) {
                    const float lo = __builtin_bit_cast(float, qq[e] << 16), hi = __builtin_bit_cast(float, qq[e] & 0xffff0000u);
                    g0 += lo * km[g * 128 + 8 * c + 2 * e] + hi * km[g * 128 + 8 * c + 2 * e + 1];
                    g1 += lo * km[(g + 4) * 128 + 8 * c + 2 * e] + hi * km[(g + 4) * 128 + 8 * c + 2 * e + 1];
                }
            }
            float gt[8];
#pragma unroll
            for (int j = 0; j < 8; ++j) { const float v = __shfl(j < 4 ? g0 : g1, lq + 16 * (j & 3)); gt[j] = (j < qb) ? v : -INFINITY; }
            unsigned sm = 0u;
#pragma unroll
            for (int j = 0; j < 8; ++j) {
                int cnt = 0;
#pragma unroll
                for (int j2 = 0; j2 < 8; ++j2) if (j2 != j) cnt += (int)((j2 < j) ? (gt[j2] >= gt[j]) : (gt[j2] > gt[j]));
                sm |= (cnt < 3) ? (1u << j) : 0u;
            }
            selmask[st] = sm & ((1u << qb) - 1u);
        }
    }
    const int nt = 4 + 4 * qb;
    bf16x8 qf[2][DK / 32];
#pragma unroll
    for (int st = 0; st < 2; ++st) {
        const GAS bf16_t* qrow = Qb + (size_t)qpos[st] * ld + 8 * g;
#pragma unroll
        for (int ks = 0; ks < DK / 32; ++ks) qf[st][ks] = *(const GAS bf16x8*)(qrow + 32 * ks);
    }
    f32x4 o[2][DV / 16];
#pragma unroll
    for (int st = 0; st < 2; ++st)
#pragma unroll
        for (int dt = 0; dt < DV / 16; ++dt) o[st][dt] = (f32x4){0.f, 0.f, 0.f, 0.f};
    float mrow[2] = {-1e30f, -1e30f}, lsum[2] = {0.f, 0.f};
    u32x4 kreg[KCH], vreg[VCH];
#define MB_KEY0(ti) ((ti) < 4 ? (q0 + 64 * (ti)) : 64 * ((ti) - 4))
#define MB_GLOAD(key0) do { int tq = tid; asm volatile("" : "+v"(tq)); \
        _Pragma("unroll") for (int j = 0; j < KCH; ++j) { const unsigned cidx = (unsigned)tq + NTHREADS * j; kreg[j] = *(const GAS u32x4*)(Kb + (size_t)((key0) + cidx / KCPR) * ld + (cidx % KCPR) * 8); } \
        _Pragma("unroll") for (int j = 0; j < VCH; ++j) { const unsigned cidx = (unsigned)tq + NTHREADS * j; vreg[j] = *(const GAS u32x4*)(Vb + (size_t)((key0) + cidx / VCPR) * ld + (cidx % VCPR) * 8); } } while (0)
#define MB_LWRITE(buf) do { int tq = tid; asm volatile("" : "+v"(tq)); \
        _Pragma("unroll") for (int j = 0; j < KCH; ++j) { const unsigned cidx = (unsigned)tq + NTHREADS * j; *(LAS u32x4*)(lds + OFF_K + (buf) * 64 * KRS + (cidx / KCPR) * KRS + (cidx % KCPR) * 16) = kreg[j]; } \
        _Pragma("unroll") for (int j = 0; j < VCH; ++j) { const unsigned cidx = (unsigned)tq + NTHREADS * j; *(LAS u32x4*)(lds + OFF_V + (buf) * 64 * VRS + (cidx / VCPR) * VRS + (cidx % VCPR) * 16) = vreg[j]; } } while (0)
    MB_GLOAD(MB_KEY0(0));
    MB_LWRITE(0);
    __syncthreads();
    for (int ti = 0; ti < nt; ++ti) {
        const int buf = ti & 1;
        const int key0 = MB_KEY0(ti);
        const int nk0 = MB_KEY0(ti + 1);
        if (ti + 1 < nt) MB_GLOAD(nk0);
        const bool diag = ti < 4;
        const unsigned bit = diag ? 0u : (1u << ((ti - 4) >> 2));
        bool active;
        if (diag) active = (64 * ti <= 32 * w + 31);
        else active = __any(((selmask[0] | selmask[1]) & bit) != 0u) != 0;
        if (active) {
            f32x4 s[2][4];
#pragma unroll
            for (int st = 0; st < 2; ++st)
#pragma unroll
                for (int kt = 0; kt < 4; ++kt) s[st][kt] = (f32x4){0.f, 0.f, 0.f, 0.f};
            const LAS unsigned char* kbase = lds + OFF_K + buf * 64 * KRS + lq * KRS + g * 16;
#pragma unroll
            for (int ks = 0; ks < DK / 32; ++ks)
#pragma unroll
                for (int kt = 0; kt < 4; ++kt) {
                    const bf16x8 kf = *(const LAS bf16x8*)(kbase + kt * 16 * KRS + ks * 64);
                    s[0][kt] = __builtin_amdgcn_mfma_f32_16x16x32_bf16(kf, qf[0][ks], s[0][kt], 0, 0, 0);
                    s[1][kt] = __builtin_amdgcn_mfma_f32_16x16x32_bf16(kf, qf[1][ks], s[1][kt], 0, 0, 0);
                }
            unsigned pk[2][4][2];
            const float NEG = -INFINITY;
#pragma unroll
            for (int st = 0; st < 2; ++st) {
                if (diag) {
#pragma unroll
                    for (int kt = 0; kt < 4; ++kt)
#pragma unroll
                        for (int r = 0; r < 4; ++r) if (key0 + 16 * kt + 4 * g + r > qpos[st]) s[st][kt][r] = NEG;
                } else if (!(selmask[st] & bit)) {
#pragma unroll
                    for (int kt = 0; kt < 4; ++kt) s[st][kt] = (f32x4){NEG, NEG, NEG, NEG};
                }
                float mx = NEG;
#pragma unroll
                for (int kt = 0; kt < 4; ++kt) mx = fmaxf(mx, fmaxf(fmaxf(s[st][kt][0], s[st][kt][1]), fmaxf(s[st][kt][2], s[st][kt][3])));
                mx = fmaxf(mx, __shfl_xor(mx, 16)); mx = fmaxf(mx, __shfl_xor(mx, 32));
                const float mnew = fmaxf(mrow[st], mx);
                const float alpha = __builtin_amdgcn_exp2f(mrow[st] - mnew);
                mrow[st] = mnew;
                float ps = 0.f;
#pragma unroll
                for (int kt = 0; kt < 4; ++kt) {
#pragma unroll
                    for (int r = 0; r < 4; ++r) { s[st][kt][r] = __builtin_amdgcn_exp2f(s[st][kt][r] - mnew); ps += s[st][kt][r]; }
                    pk[st][kt][0] = cvtpk(s[st][kt][0], s[st][kt][1]); pk[st][kt][1] = cvtpk(s[st][kt][2], s[st][kt][3]);
                }
                lsum[st] = lsum[st] * alpha + ps;
#pragma unroll
                for (int dt = 0; dt < DV / 16; ++dt) o[st][dt] = o[st][dt] * alpha;
            }
            const LAS unsigned char* vbase = lds + OFF_V + buf * 64 * VRS + (4 * g + (lq >> 2)) * VRS + (lane & 3) * 8;
            {
                constexpr int GPS = DV / 64, NG = 2 * GPS;
                bf16x8 pf[2][2];
#pragma unroll
                for (int st = 0; st < 2; ++st)
#pragma unroll
                    for (int s2 = 0; s2 < 2; ++s2) { const u32x4 pw = (u32x4){pk[st][2 * s2][0], pk[st][2 * s2][1], pk[st][2 * s2 + 1][0], pk[st][2 * s2 + 1][1]}; pf[st][s2] = __builtin_bit_cast(bf16x8, pw); }
                bf16x8 vfa[4], vfb[4];
#define MB_LOADV(dst, gi) do { _Pragma("unroll") for (int j = 0; j < 4; ++j) { const int dt_ = ((gi) % GPS) * 4 + j; \
                    const s16x4 v0 = __builtin_amdgcn_ds_read_tr16_b64_v4i16((LAS s16x4*)(vbase + (32 * ((gi) / GPS)) * VRS + dt_ * 32)); \
                    const s16x4 v1 = __builtin_amdgcn_ds_read_tr16_b64_v4i16((LAS s16x4*)(vbase + (32 * ((gi) / GPS) + 16) * VRS + dt_ * 32)); \
                    dst[j] = (bf16x8){v0[0], v0[1], v0[2], v0[3], v1[0], v1[1], v1[2], v1[3]}; } } while (0)
#define MB_MMAV(src, gi) do { _Pragma("unroll") for (int j = 0; j < 4; ++j) { const int dt_ = ((gi) % GPS) * 4 + j; \
                    o[0][dt_] = __builtin_amdgcn_mfma_f32_16x16x32_bf16(src[j], pf[0][(gi) / GPS], o[0][dt_], 0, 0, 0); \
                    o[1][dt_] = __builtin_amdgcn_mfma_f32_16x16x32_bf16(src[j], pf[1][(gi) / GPS], o[1][dt_], 0, 0, 0); } } while (0)
                MB_LOADV(vfa, 0);
#pragma unroll
                for (int gi = 0; gi < NG; gi += 2) {
                    MB_LOADV(vfb, gi + 1);
                    MB_MMAV(vfa, gi);
                    __builtin_amdgcn_sched_barrier(0);
                    if (gi + 2 < NG) MB_LOADV(vfa, gi + 2);
                    MB_MMAV(vfb, gi + 1);
                    __builtin_amdgcn_sched_barrier(0);
                }
#undef MB_LOADV
#undef MB_MMAV
            }
        }
        if (ti + 1 < nt) MB_LWRITE(buf ^ 1);
        __syncthreads();
    }
#undef MB_KEY0
#undef MB_GLOAD
#undef MB_LWRITE
    int te = tid; asm volatile("" : "+v"(te));
    const int g_e = (te & 63) >> 4;
#pragma unroll
    for (int st = 0; st < 2; ++st) {
        const int qpos_e = q0 + 32 * (te >> 6) + 16 * st + (te & 15);
        float l = lsum[st]; l += __shfl_xor(l, 16); l += __shfl_xor(l, 32);
        const float inv = __builtin_amdgcn_rcpf(l);
        GAS bf16_t* orow = Out + (size_t)qpos_e * DMODEL + 4 * g_e;
#pragma unroll
        for (int dt = 0; dt < DV / 16; ++dt) { u32x2 wv; wv.x = cvtpk(o[st][dt][0] * inv, o[st][dt][1] * inv); wv.y = cvtpk(o[st][dt][2] * inv, o[st][dt][3] * inv); *(GAS u32x2*)(orow + 16 * dt) = wv; }
    }
}

__device__ __forceinline__ void xpose_item(const GAS float* __restrict__ W, int K, int N, GAS bf16_t* __restrict__ dst, const GAS float* __restrict__ gain, int src_n0, int dst_n0, int k0,
                                           LAS unsigned char* scr, int lane) {
    constexpr int RS = 260;
#pragma unroll 16
    for (int i = 0; i < 32; ++i) {
        const int kk = 2 * i + (lane >> 5);
        f32x4 v = __builtin_nontemporal_load((const GAS f32x4*)(W + (size_t)(k0 + kk) * N + src_n0 + 4 * (lane & 31)));
        const float gg = gain ? gain[k0 + kk] : 1.0f;
        v = v * gg;
        LAS unsigned* p = (LAS unsigned*)(scr + kk * RS + 8 * (lane & 31));
        p[0] = cvtpk(v[0], v[1]); p[1] = cvtpk(v[2], v[3]);
    }
    asm volatile("s_waitcnt lgkmcnt(0)" ::: "memory");
    const int c = lane & 7, r = lane >> 3;
#pragma unroll 4
    for (int j = 0; j < 16; ++j) {
        const int nn = r + 8 * j;
        const LAS unsigned short* s = (const LAS unsigned short*)(scr + (8 * c) * RS + nn * 2);
        unsigned e[8];
#pragma unroll
        for (int i = 0; i < 8; ++i) e[i] = s[i * (RS / 2)];
        u32x4 o; o.x = e[0] | (e[1] << 16); o.y = e[2] | (e[3] << 16); o.z = e[4] | (e[5] << 16); o.w = e[6] | (e[7] << 16);
        __builtin_nontemporal_store(o, (GAS u32x4*)(dst + (size_t)(dst_n0 + nn) * K + k0 + 8 * c));
    }
    asm volatile("s_waitcnt lgkmcnt(0)" ::: "memory");
}

constexpr int CV_GU = 2816, CV_DN = 1408, CV_QKV = 1536, CV_MO = 512, CV_RIN = 2048, CV_RO = 512;
constexpr int CV_P0 = 0, CV_MB = CV_GU + CV_DN + CV_QKV, CV_RT = CV_MB + CV_MO + 2 * CV_GU + 2 * CV_DN + CV_RIN, CV_END = CV_RT + CV_RO + CV_GU + CV_DN;
static_assert(CV_MB == 5760 && CV_RT == 16768 && CV_END == 21504, "conversion items");
struct ConvPtrs { const GAS float* gu; const GAS float* dn; const GAS float* qkv; const GAS float* mo; const GAS float* rin; const GAS float* ro; const GAS float* gain;
                  GAS bf16_t* WGU; GAS bf16_t* WDN; GAS bf16_t* WQKV; GAS bf16_t* WMO; GAS bf16_t* WRIN; GAS bf16_t* WRO; };
__device__ __forceinline__ void conv_item(const ConvPtrs& P, int it, LAS unsigned char* scr, int lane) {
    int mt, mi = 0, r = it;
    if (r < CV_MB) { if (r < CV_GU) { mt = 0; mi = 0; } else if ((r -= CV_GU) < CV_DN) { mt = 1; mi = 0; } else { r -= CV_DN; mt = 2; } }
    else if (r < CV_RT) { r -= CV_MB;
        if (r < CV_MO) mt = 3; else if ((r -= CV_MO) < CV_GU) { mt = 0; mi = 1; } else if ((r -= CV_GU) < CV_DN) { mt = 1; mi = 1; } else if ((r -= CV_DN) < CV_GU) { mt = 0; mi = 2; }
        else if ((r -= CV_GU) < CV_DN) { mt = 1; mi = 2; } else { r -= CV_DN; mt = 4; } }
    else { r -= CV_RT; if (r < CV_RO) mt = 5; else if ((r -= CV_RO) < CV_GU) { mt = 0; mi = 3; } else { r -= CV_GU; mt = 1; mi = 3; } }
    if (mt == 0) { const int kb = r / 88, nb = r % 88; const int L = mi >> 1, f = mi & 1;
        xpose_item(P.gu + (size_t)mi * GU_ELEMS, DMODEL, 2 * FFN, P.WGU + (size_t)mi * GU_ELEMS, P.gain + (L * 3 + (f ? 2 : 0)) * DMODEL, ((nb & 1) * 44 + (nb >> 1)) * 128, nb * 128, kb * 64, scr, lane); }
    else if (mt == 1) { const int kb = r / 16, nb = r % 16; xpose_item(P.dn + (size_t)mi * DN_ELEMS, FFN, DMODEL, P.WDN + (size_t)mi * DN_ELEMS, nullptr, nb * 128, nb * 128, kb * 64, scr, lane); }
    else if (mt == 2) { const int kb = r / 48, nb = r % 48; xpose_item(P.qkv, DMODEL, NQKV, P.WQKV, P.gain + (0 * 3 + 1) * DMODEL, nb * 128, nb * 128, kb * 64, scr, lane); }
    else if (mt == 3) { const int kb = r / 16, nb = r % 16; xpose_item(P.mo, DMODEL, DMODEL, P.WMO, nullptr, nb * 128, nb * 128, kb * 64, scr, lane); }
    else if (mt == 4) { const int kb = r / 64, nb = r % 64; xpose_item(P.rin, DMODEL, NRIN, P.WRIN, P.gain + (1 * 3 + 1) * DMODEL, nb * 128, nb * 128, kb * 64, scr, lane); }
    else { const int kb = r / 16, nb = r % 16; xpose_item(P.ro, DMODEL, DMODEL, P.WRO, nullptr, nb * 128, nb * 128, kb * 64, scr, lane); }
}

#define XB_TMO      128
#define XB_XCNT(j)  (256  + 64 * (j))
#define XB_XSUB(j)  (1280 + 64 * (j))
#define XB_XGEN(j)  (2304 + 64 * (j))
#define XB_TOP      3328
#define XB_TOPGEN   3392
#define XCD_BAR_WORDS 3456
#define XB_SPIN_CAP (1u << 22)
__device__ __forceinline__ unsigned xb_ld(unsigned* p)              { return __hip_atomic_load(p, __ATOMIC_RELAXED, __HIP_MEMORY_SCOPE_AGENT); }
__device__ __forceinline__ unsigned xb_add(unsigned* p, unsigned v) { return __hip_atomic_fetch_add(p, v, __ATOMIC_RELAXED, __HIP_MEMORY_SCOPE_AGENT); }
__device__ __forceinline__ unsigned xb_xcc_id() { return (unsigned)__builtin_amdgcn_s_getreg((3 << 11) | 20) & 0xFu; }
#define XB_SPIN(cond, bar) do { unsigned _sp = 0; while (cond) { __builtin_amdgcn_s_sleep(1); \
    if ((++_sp & 255u) == 0u) { if (xb_ld(&(bar)[XB_TMO])) break; if (_sp > XB_SPIN_CAP) { atomicAdd(&(bar)[XB_TMO], 1u); break; } } } } while (0)
struct XcdBarrier { unsigned* bar; unsigned x; volatile LAS unsigned* st; };
__device__ __forceinline__ XcdBarrier xcd_barrier_post(unsigned* bar, volatile LAS unsigned* st) {
    XcdBarrier b; b.bar = bar; b.x = xb_xcc_id(); b.st = st;
    if (threadIdx.x == 0) (void)xb_add(&bar[XB_XCNT(b.x)], 1u);
    return b;
}
__device__ __forceinline__ void xcd_barrier_complete(unsigned* bar, unsigned x, unsigned& nloc, unsigned& nx) {
    const unsigned G = gridDim.x * gridDim.y * gridDim.z;
    unsigned sum, cnt, mine, sp = 0u;
    for (;;) {
        sum = 0u; cnt = 0u; mine = 0u;
#pragma unroll
        for (unsigned j = 0; j < 16; ++j) { const unsigned c = xb_ld(&bar[XB_XCNT(j)]); sum += c; cnt += (c > 0u) ? 1u : 0u; mine = (j == x) ? c : mine; }
        if (sum == G) break;
        __builtin_amdgcn_s_sleep(1);
        if ((++sp & 255u) == 0u) { if (xb_ld(&bar[XB_TMO])) break; if (sp > XB_SPIN_CAP) { atomicAdd(&bar[XB_TMO], 1u); break; } }
    }
    nloc = mine > 0u ? mine : 1u; nx = cnt > 0u ? cnt : 1u;
}
__device__ __forceinline__ void xcd_barrier(const XcdBarrier& b) {
    asm volatile("s_waitcnt vmcnt(0)" ::: "memory");
    __syncthreads();
    if (threadIdx.x == 0) {
        unsigned* bar = b.bar;
        __builtin_amdgcn_s_waitcnt(0);
        unsigned nloc = b.st[0], nx = b.st[1];
        if (nloc == 0u) { xcd_barrier_complete(bar, b.x, nloc, nx); b.st[0] = nloc; b.st[1] = nx; }
        const unsigned old = xb_add(&bar[XB_XSUB(b.x)], 1u);
        const unsigned gen = old / nloc;
        if (old + 1u == (gen + 1u) * nloc) {
            __builtin_amdgcn_fence(__ATOMIC_RELEASE, "agent");
            asm volatile("s_waitcnt vmcnt(0)" ::: "memory");
            const unsigned og = xb_add(&bar[XB_TOP], 1u);
            const unsigned tg = og / nx;
            if (og + 1u == (tg + 1u) * nx) xb_add(&bar[XB_TOPGEN], 1u);
            else XB_SPIN(xb_ld(&bar[XB_TOPGEN]) == tg, bar);
            __builtin_amdgcn_fence(__ATOMIC_ACQUIRE, "agent");
            xb_add(&bar[XB_XGEN(b.x)], 1u);
            asm volatile("s_waitcnt vmcnt(0)" ::: "memory");
        } else {
            XB_SPIN(xb_ld(&bar[XB_XGEN(b.x)]) == gen, bar);
            __builtin_amdgcn_fence(__ATOMIC_ACQUIRE, "agent");
            asm volatile("s_waitcnt vmcnt(0)" ::: "memory");
        }
    }
    __syncthreads();
}

struct Args { const float* in[10]; float* out; unsigned char* ws; int ph_lo, ph_hi, coop, pad; };

__global__ void __launch_bounds__(NTHREADS, 2) mk_fwd(Args args) {
    extern __shared__ __attribute__((aligned(16))) unsigned char lds_raw[];
    LAS unsigned char* lds = (LAS unsigned char*)lds_raw;
    volatile LAS unsigned* bst = (volatile LAS unsigned*)(lds + LDS_BYTES - 64);
    if (threadIdx.x < 2) bst[threadIdx.x] = 0u;
    __syncthreads();
    XcdBarrier xbar; xbar.bar = (unsigned*)(args.ws + WS_BAR); xbar.x = 0; xbar.st = bst;
    if (args.coop) xbar = xcd_barrier_post((unsigned*)(args.ws + WS_BAR), bst);
    int dup_done = 0;
    for (int ph = args.ph_lo; ph < args.ph_hi; ++ph) {
      for (int sub = 0; sub < 3; ++sub) {
        int tid = threadIdx.x; asm volatile("" : "+v"(tid));
        const int lane = tid & 63, wave = __builtin_amdgcn_readfirstlane(tid >> 6);
        int G = gridDim.x, bx = blockIdx.x; asm volatile("" : "+s"(G), "+s"(bx));
        const int vcu = (G % 8 == 0) ? (bx % 8) * (G / 8) + bx / 8 : bx;
        GAS unsigned char* ws = (GAS unsigned char*)args.ws; asm volatile("" : "+s"(ws));
        GAS u64* SS = (GAS u64*)(ws + WS_SS);
        GAS float* KSUM = (GAS float*)(ws + WS_KSUM);
        GAS bf16_t* WGU = (GAS bf16_t*)(ws + WS_WGU); GAS bf16_t* WDN = (GAS bf16_t*)(ws + WS_WDN); GAS bf16_t* WQKV = (GAS bf16_t*)(ws + WS_WQKV); GAS bf16_t* WMO = (GAS bf16_t*)(ws + WS_WMO);
        GAS bf16_t* WRIN = (GAS bf16_t*)(ws + WS_WRIN); GAS bf16_t* WRO = (GAS bf16_t*)(ws + WS_WRO);
        GAS bf16_t* XB = (GAS bf16_t*)(ws + WS_XB); GAS bf16_t* ACT = (GAS bf16_t*)(ws + WS_ACT); GAS bf16_t* QKV = (GAS bf16_t*)(ws + WS_QKV); GAS bf16_t* AO = (GAS bf16_t*)(ws + WS_AO);
        const GAS float* x_in = ((const GAS float*)args.in[0]); const GAS float* norm_gain = ((const GAS float*)args.in[1]);
        GAS float* out = ((GAS float*)args.out);
        if (sub != 1) {
            int c_lo = 0, c_hi = 0, widx = 0, nw = 1;
            if (ph == 0 && sub == 2) { c_lo = CV_P0; c_hi = CV_GU; widx = vcu * NWAVES + wave; nw = G * NWAVES; }
            else if (ph == 1 && sub == 2 && 2 * bx >= G) { c_lo = CV_GU; c_hi = CV_MB; widx = (bx - (G >> 1)) * NWAVES + wave; nw = (G - (G >> 1)) * NWAVES; }
            else if (ph == 4 || ph == 11) {
                const int lo = (ph == 4) ? CV_MB : CV_RT, hi = (ph == 4) ? CV_RT : CV_END, mid = lo + ((hi - lo) >> 1);
                if (sub == 0 && (vcu & 1)) { c_lo = lo; c_hi = mid; } else if (sub == 2 && !(vcu & 1)) { c_lo = mid; c_hi = hi; }
                widx = (vcu >> 1) * NWAVES + wave; nw = (G >> 1) * NWAVES;
            }
            if (c_hi > c_lo) {
                ConvPtrs P{(const GAS float*)args.in[2], (const GAS float*)args.in[3], (const GAS float*)args.in[4], (const GAS float*)args.in[5], (const GAS float*)args.in[6], (const GAS float*)args.in[7], norm_gain,
                           WGU, WDN, WQKV, WMO, WRIN, WRO};
                LAS unsigned char* scr = lds + wave * 16640;
                for (int it = c_lo + widx; it < c_hi; it += nw) conv_item(P, it, scr, lane);
            }
            __syncthreads();
        } else if (ph == 0 && (PH_MASK & 1)) {
            const int gw = vcu * NWAVES + wave, NGW = G * NWAVES;
            for (int m = gw; m < MTOK; m += NGW) {
                const GAS f32x4* xr = (const GAS f32x4*)(x_in + (size_t)m * DMODEL) + lane;
                GAS u32x2* o8 = (GAS u32x2*)(XB + (size_t)m * DMODEL) + lane;
                float s = 0.f;
#pragma unroll
                for (int j = 0; j < 8; ++j) { const f32x4 v = __builtin_nontemporal_load(xr + 64 * j); s += (v[0] * v[0] + v[1] * v[1]) + (v[2] * v[2] + v[3] * v[3]); u32x2 wv; wv.x = cvtpk(v[0], v[1]); wv.y = cvtpk(v[2], v[3]); o8[64 * j] = wv; }
                s = wave_sum(s);
                if (lane == 0) SS[m] = ss_enc(s);
            }
            for (int i = bx * NTHREADS + tid; i < 6 * MTOK; i += G * NTHREADS) SS[MTOK + i] = 0ull;
            for (int i = bx * NTHREADS + tid; i < 32 * DMODEL; i += G * NTHREADS) KSUM[i] = 0.f;
        } else if (ph == 15 && (PH_MASK & 2)) {
            const GAS float* fn = ((const GAS float*)args.in[9]); const GAS u64* ssf = SS + 6 * MTOK;
            for (int i = bx * NTHREADS + tid; i < MTOK * (DMODEL / 4); i += G * NTHREADS) {
                const int row = i >> 9, c4 = i & 511;
                const float rs = __builtin_amdgcn_rsqf(ss_dec(ssf[row]) * (1.0f / DMODEL) + RMS_EPS);
                const u32x2 bb = ((const GAS u32x2*)XB)[i]; const f32x4 gg = ((const GAS f32x4*)fn)[c4];
                f32x4 v = (f32x4){__builtin_bit_cast(float, bb.x << 16), __builtin_bit_cast(float, bb.x & 0xffff0000u), __builtin_bit_cast(float, bb.y << 16), __builtin_bit_cast(float, bb.y & 0xffff0000u)};
                v = v * rs * gg; __builtin_nontemporal_store(v, (GAS f32x4*)out + i);
            }
        } else {
            const int L = (ph - 1) / 7, step = (ph - 1) % 7;
            if ((step == 0 || step == 5) && (PH_MASK & 4)) {
                const int f = (step == 5);
                pg8::Gemm gm{XB, WGU + (size_t)(L * 2 + f) * GU_ELEMS, MTOK, 2 * FFN, DMODEL};
                pg8::StaticOrder S; S.init(MTOK, 2 * FFN, G, bx);
                pg8::EpiGU E{ACT, SS + (size_t)(3 * L + (f ? 2 : 0)) * MTOK};
                pg8::gemm_phase<pg8::EpiGU, pg8::StaticOrder, true, true>(lds, gm, S, E, tid);
            } else if ((step == 1 || step == 6 || step == 4) && (PH_MASK & 8)) {
                pg8::Gemm gm; pg8::EpiRes E;
                if (step == 4) { gm = pg8::Gemm{AO, L == 0 ? WMO : WRO, MTOK, DMODEL, DMODEL}; E = pg8::EpiRes{XB, SS + (size_t)(3 * L + 2) * MTOK, 1.0f}; }
                else { const int f = (step == 6); gm = pg8::Gemm{ACT, WDN + (size_t)(L * 2 + f) * DN_ELEMS, MTOK, DMODEL, FFN};
                       E = pg8::EpiRes{XB, SS + (size_t)(3 * L + (f ? 3 : 1)) * MTOK, 0.5f}; }
                pg8::StaticOrder S; S.init(MTOK, DMODEL, G, bx);
                pg8::gemm_phase<pg8::EpiRes, pg8::StaticOrder, true, true>(lds, gm, S, E, tid);
            } else if (step == 2) {
                if (L == 0 && (PH_MASK & 16)) {
                    pg8::Gemm gm{XB, WQKV, MTOK, NQKV, DMODEL}; pg8::StaticOrder S; S.init(MTOK, NQKV, G, bx);
                    pg8::EpiQKV E{QKV, SS + 1 * MTOK, KSUM};
                    pg8::gemm_phase<pg8::EpiQKV, pg8::StaticOrder, true, true>(lds, gm, S, E, tid);
                } else if (PH_MASK & 32) {
                    pg8::Gemm gm{XB, WRIN, MTOK, NRIN, DMODEL}; pg8::StaticOrder S; S.init(MTOK, NRIN, G, bx);
                    pg8::EpiRIN E{QKV, SS + 4 * MTOK};
                    pg8::gemm_phase<pg8::EpiRIN, pg8::StaticOrder, true, true>(lds, gm, S, E, tid);
                }
            } else {
                if (L == 0 && (PH_MASK & 64)) {
                    for (int p = vcu; p < 256; p += G) {
                        const int bh = p >> 2, s = p & 3, b = bh >> 4, h = bh & 15;
                        const GAS bf16_t* Qb = QKV + (size_t)b * SEQ * NQKV + h * 128;
                        for (int e = 0; e < 2; ++e) {
                            const int qb = e ? 7 - s : s;
                            moba_unit256(lds, Qb, Qb + 2048, Qb + 4096, qb, AO + (size_t)b * SEQ * DMODEL + h * 128, KSUM + (size_t)b * 8 * DMODEL + h * 128, tid);
                        }
                    }
                } else if (PH_MASK & 128) {
                    const GAS float* gnp = ((const GAS float*)args.in[8]);
                    for (int p = vcu; p < 256; p += G) {
                        const int bh = p >> 3, s = p & 7, b = bh >> 3, h = bh & 7;
                        const GAS bf16_t* Qb = QKV + (size_t)b * SEQ * NRIN + h * 256;
                        const float lg2 = __builtin_amdgcn_logf(1.0f - __builtin_amdgcn_exp2f(-5.0f - (float)h));
                        for (int e = 0; e < 2; ++e) {
                            const int u = e ? 15 - s : s;
                            attn_unit<256, 256, false>(lds, Qb, Qb + 2048, Qb + 4096, NRIN, u * 128, AO + (size_t)b * SEQ * DMODEL + h * 256,
                                                       nullptr, lg2, Qb + 6144, gnp + h * 256, tid);
                        }
                    }
                }
            }
        }
      }
        if (PROBE_DUP != 0 && ((PROBE_DUP >> ph) & 1) && !dup_done) { dup_done = 1; --ph; } else dup_done = 0;
        if (ph + 1 < args.ph_hi) {
            if (args.coop) {
                if (args.coop == 2) {
                    asm volatile("s_waitcnt vmcnt(0) lgkmcnt(0)" ::: "memory");
                    cg::this_grid().sync();
                    __builtin_amdgcn_fence(__ATOMIC_ACQUIRE, "agent");
                    asm volatile("s_waitcnt vmcnt(0)" ::: "memory");
                } else xcd_barrier(xbar);
            }
        }
    }
}

extern "C" void kernel_launch(void* const* d_in, const int* in_sizes, int n_in, void* d_out, int out_size, void* d_ws, size_t ws_size, hipStream_t stream) {
    static int grid = 0;
    if (grid == 0) {
        if (n_in != 10 || ws_size < WS_END) { fprintf(stderr, "kernel_launch: unexpected inputs (n_in %d, ws %zu)\n", n_in, ws_size); grid = -1; return; }
        int dev = 0, cus = 0, per_cu = 0;
        hipGetDevice(&dev);
        hipDeviceGetAttribute(&cus, hipDeviceAttributeMultiprocessorCount, dev);
        if (hipFuncSetAttribute((const void*)mk_fwd, hipFuncAttributeMaxDynamicSharedMemorySize, LDS_BYTES) != hipSuccess) { fprintf(stderr, "kernel_launch: hipFuncSetAttribute failed\n"); grid = -1; return; }
        if (hipOccupancyMaxActiveBlocksPerMultiprocessor(&per_cu, (const void*)mk_fwd, NTHREADS, LDS_BYTES) != hipSuccess || per_cu < 1) { fprintf(stderr, "kernel_launch: occupancy query says %d\n", per_cu); per_cu = 1; }
        (void)hipGetLastError();
        grid = cus * 1;
    }
    if (grid < 0) return;
    Args a{};
    for (int i = 0; i < 10; ++i) a.in[i] = (const float*)d_in[i];
    a.out = (float*)d_out; a.ws = (unsigned char*)d_ws; a.pad = 0;
#if MK_ONE_LAUNCH
    if (hipMemsetAsync((char*)d_ws + WS_BAR, 0, XCD_BAR_WORDS * 4, stream) != hipSuccess) { fprintf(stderr, "kernel_launch: memset of barrier words failed\n"); return; }
    a.ph_lo = 0; a.ph_hi = 16; a.coop = 1;
    void* kargs[] = {&a};
    hipError_t e = hipLaunchCooperativeKernel((const void*)mk_fwd, dim3(grid), dim3(NTHREADS), kargs, LDS_BYTES, stream);
    if (e != hipSuccess) fprintf(stderr, "cooperative launch failed: %s (grid %d)\n", hipGetErrorString(e), grid);
#else
    for (int ph = 0; ph < 16; ++ph) {
        a.ph_lo = ph; a.ph_hi = ph + 1; a.coop = 0;
        hipLaunchKernelGGL(mk_fwd, dim3(grid), dim3(NTHREADS), LDS_BYTES, stream, a);
    }
#endif
}
```

```cpp
#include <hip/hip_runtime.h>
#include <hip/hip_cooperative_groups.h>
#include <cstdio>
#include <cstdint>
namespace cg = cooperative_groups;

#ifndef PH_MASK
#define PH_MASK 255
#endif
#ifndef PROBE_DUP
#define PROBE_DUP 0
#endif
#ifndef MK_ONE_LAUNCH
#define MK_ONE_LAUNCH 1
#endif

#define LAS __attribute__((address_space(3)))
#define GAS __attribute__((address_space(1)))
typedef unsigned short bf16_t;
typedef short bf16x8 __attribute__((ext_vector_type(8)));
typedef short s16x4 __attribute__((ext_vector_type(4)));
typedef float f32x4 __attribute__((ext_vector_type(4)));
typedef float f32x2 __attribute__((ext_vector_type(2)));
typedef unsigned u32x4 __attribute__((ext_vector_type(4)));
typedef unsigned u32x2 __attribute__((ext_vector_type(2)));
typedef __bf16 bf16x2_t __attribute__((ext_vector_type(2)));

constexpr int DMODEL = 2048, NBATCH = 4, SEQ = 2048, MTOK = NBATCH * SEQ, FFN = 5632;
constexpr int NQKV = 6144, NRIN = 8192;
constexpr float RMS_EPS = 1e-6f;
constexpr float LOG2E = 1.4426950408889634f;

constexpr size_t MiB = 1u << 20;
constexpr size_t WS_SS = 0;
constexpr size_t WS_KSUM = 512 * 1024;
constexpr size_t WS_BAR = 768 * 1024;
constexpr size_t WS_WGU = 1 * MiB;
constexpr size_t WS_WDN = WS_WGU + 176 * MiB;
constexpr size_t WS_WQKV = WS_WDN + 88 * MiB;
constexpr size_t WS_WMO = WS_WQKV + 24 * MiB;
constexpr size_t WS_WRIN = WS_WMO + 8 * MiB;
constexpr size_t WS_WRO = WS_WRIN + 32 * MiB;
constexpr size_t WS_XB = WS_WRO + 8 * MiB;
constexpr size_t WS_ACT = WS_XB + 32 * MiB;
constexpr size_t WS_QKV = WS_ACT + 88 * MiB;
constexpr size_t WS_AO = WS_QKV + 128 * MiB;
constexpr size_t WS_END = WS_AO + 32 * MiB;
constexpr size_t GU_ELEMS = (size_t)2 * FFN * DMODEL, DN_ELEMS = (size_t)DMODEL * FFN;

constexpr int NWAVES = 8, NTHREADS = 512;
constexpr int LDS_BYTES = 147456;

__device__ __forceinline__ unsigned cvtpk(float lo, float hi) { f32x2 v = {lo, hi}; bf16x2_t b = __builtin_convertvector(v, bf16x2_t); return __builtin_bit_cast(unsigned, b); }
__device__ __forceinline__ float bf2f(unsigned short h) { return __builtin_bit_cast(float, (unsigned)h << 16); }
__device__ __forceinline__ float silu_f(float x) { return x * __builtin_amdgcn_rcpf(1.0f + __builtin_amdgcn_exp2f(-x * LOG2E)); }
typedef unsigned long long u64;
__device__ __forceinline__ u64 ss_enc(float v) { const float fl = __builtin_floorf(v); return ((u64)(unsigned)fl << 32) | (u64)(unsigned)((v - fl) * 4294967296.0f); }
__device__ __forceinline__ float ss_dec(u64 v) { return (float)(unsigned)(v >> 32) + (float)(unsigned)v * 2.3283064365386963e-10f; }
__device__ __forceinline__ float wave_sum(float v) {
#pragma unroll
    for (int o = 1; o < 64; o <<= 1) v += __shfl_xor(v, o);
    return v;
}

namespace pg8 {
constexpr int BM = 256, BK = 64, HALF = 128, HTB = HALF * BK * 2, STAGE_BYTES = 8 * HTB, NXCD = 8, WGM = 8;
__host__ __device__ __forceinline__ int lds_byte(int r, int c) { const int st = (r >> 4) * 2 + (c >> 5), rr = r & 15, cc = c & 31, ob = rr * 64 + cc * 2; return st * 1024 + (ob ^ (((ob >> 9) & 1) << 5)); }
__host__ __device__ __forceinline__ void stage_rc(int b, int& R, int& C) { const int st = b / 1024, sb = b % 1024, swz = sb ^ (((sb >> 9) & 1) << 5); R = (st >> 1) * 16 + swz / 64; C = (st & 1) * 32 + (swz % 64) / 2; }
__host__ __device__ __forceinline__ int perm32(int rho) { const int n = rho >> 4, i = rho & 15; return 8 * (i >> 2) + 4 * n + (i & 3); }

struct Unit { int pm, pn; };
struct Gemm { const GAS bf16_t* A; const GAS bf16_t* Bt; int M, N, K; };

struct StaticOrder {
    int nM, nN, nwg, G, c;
    __host__ __device__ void init(int M, int N, int G_, int c_) { nM = M / BM; nN = N / BM; nwg = nM * nN; G = G_; c = c_; }
    __host__ __device__ bool next(int i, Unit& u) const {
        const long L = (long)i * G + c; if (L >= nwg) return false;
        int wgid = (int)L; { const int q = nwg / NXCD, r = nwg % NXCD, xcd = wgid % NXCD, off = wgid / NXCD; wgid = (xcd < r ? xcd * (q + 1) : r * (q + 1) + (xcd - r) * q) + off; }
        const int nig = WGM * nN, gid = wgid / nig, fm = gid * WGM, gsz = (nM - fm) < WGM ? (nM - fm) : WGM;
        u.pm = fm + ((wgid % nig) % gsz); u.pn = (wgid % nig) / gsz; return true;
    }
};


struct EpiGU {
    static constexpr bool PERM = true;
    GAS bf16_t* O; const GAS u64* ss;
    __device__ __forceinline__ void operator()(const f32x4 (&acc)[2][2][4][2], const Unit& u, int wr, int wc, int fr, int fq) const {
        const int row0 = u.pm * BM + wr * 64 + fr; const int col0 = u.pn * HALF + wc * 32 + 8 * fq;
        u64 ssv[8];
#pragma unroll
        for (int rg = 0; rg < 8; ++rg) ssv[rg] = ss[row0 + (rg >> 2) * HALF + (rg & 3) * 16];
#pragma unroll
        for (int ai = 0; ai < 2; ++ai)
#pragma unroll
            for (int m = 0; m < 4; ++m) {
                const int row = row0 + ai * HALF + m * 16;
                const float rs = __builtin_amdgcn_rsqf(ss_dec(ssv[ai * 4 + m]) * (1.0f / DMODEL) + RMS_EPS);
                const float rs2 = rs * rs, nrs = -rs * LOG2E;
                float v[8];
#pragma unroll
                for (int n = 0; n < 2; ++n)
#pragma unroll
                    for (int i = 0; i < 4; ++i) { const float ga = acc[ai][0][m][n][i], ua = acc[ai][1][m][n][i];
                        v[4 * n + i] = (ga * ua) * (rs2 * __builtin_amdgcn_rcpf(1.0f + __builtin_amdgcn_exp2f(ga * nrs))); }
                u32x4 w; w.x = cvtpk(v[0], v[1]); w.y = cvtpk(v[2], v[3]); w.z = cvtpk(v[4], v[5]); w.w = cvtpk(v[6], v[7]);
                *(GAS u32x4*)(O + (size_t)row * FFN + col0) = w;
                asm volatile("" ::: "memory");
            }
    }
};

struct EpiRes {
    static constexpr bool PERM = true;
    GAS bf16_t* xb; GAS u64* ss_out; float scale;
    __device__ __forceinline__ void operator()(const f32x4 (&acc)[2][2][4][2], const Unit& u, int wr, int wc, int fr, int fq) const {
        const int row0 = u.pm * BM + wr * 64 + fr; const int col0 = u.pn * BM + wc * 32 + 8 * fq;
        u32x4 bc[2], bn[2];
#pragma unroll
        for (int bj = 0; bj < 2; ++bj) bc[bj] = *(const GAS u32x4*)(xb + (size_t)row0 * DMODEL + col0 + bj * HALF);
#pragma unroll
        for (int rg = 0; rg < 8; ++rg) {
            const int ai = rg >> 2, m = rg & 3;
            const int row = row0 + ai * HALF + m * 16; const size_t off = (size_t)row * DMODEL + col0;
            if (rg + 1 < 8) {
                const size_t offn = (size_t)(row0 + ((rg + 1) >> 2) * HALF + ((rg + 1) & 3) * 16) * DMODEL + col0;
#pragma unroll
                for (int bj = 0; bj < 2; ++bj) bn[bj] = *(const GAS u32x4*)(xb + offn + bj * HALF);
            }
            asm volatile("" ::: "memory");
            float s2 = 0.f;
#pragma unroll
            for (int bj = 0; bj < 2; ++bj) {
                const u32x4 bb = bc[bj];
                unsigned wv[4];
#pragma unroll
                for (int n = 0; n < 2; ++n) {
                    const unsigned b0 = bb[2 * n], b1 = bb[2 * n + 1];
                    const f32x4 bf = (f32x4){__builtin_bit_cast(float, b0 << 16), __builtin_bit_cast(float, b0 & 0xffff0000u), __builtin_bit_cast(float, b1 << 16), __builtin_bit_cast(float, b1 & 0xffff0000u)};
                    const f32x4 o = bf + acc[ai][bj][m][n] * scale;
                    wv[2 * n] = cvtpk(o[0], o[1]); wv[2 * n + 1] = cvtpk(o[2], o[3]);
                    s2 += (o[0] * o[0] + o[1] * o[1]) + (o[2] * o[2] + o[3] * o[3]);
                }
                *(GAS u32x4*)(xb + off + bj * HALF) = (u32x4){wv[0], wv[1], wv[2], wv[3]};
            }
            s2 += __shfl_xor(s2, 16); s2 += __shfl_xor(s2, 32);
            if (fq == 0) __hip_atomic_fetch_add(ss_out + row, ss_enc(s2), __ATOMIC_RELAXED, __HIP_MEMORY_SCOPE_AGENT);
            asm volatile("" ::: "memory");
#pragma unroll
            for (int bj = 0; bj < 2; ++bj) bc[bj] = bn[bj];
        }
    }
};

struct EpiQKV {
    static constexpr bool PERM = false;
    GAS bf16_t* O; const GAS u64* ss; GAS float* ksum;
    __device__ __forceinline__ void operator()(const f32x4 (&acc)[2][2][4][2], const Unit& u, int wr, int wc, int fr, int fq) const {
        const int row0 = u.pm * BM + wr * 64 + fr; const int col0 = u.pn * BM + wc * 32 + 4 * fq;
        const int t = u.pn >> 3;
        const bool rot = (t < 2) && (wc == 0);
        const float qs = (t == 0) ? (0.08838834764831845f * LOG2E) : 1.0f;
        float invf[4];
#pragma unroll
        for (int i = 0; i < 4; ++i) invf[i] = __builtin_amdgcn_exp2f(-(float)(4 * fq + i) * (18.931568569324174f / 16.0f)) * 0.15915494309189535f;
        f32x4 csum[2][2];
#pragma unroll
        for (int bj = 0; bj < 2; ++bj)
#pragma unroll
            for (int n = 0; n < 2; ++n) csum[bj][n] = (f32x4){0.f, 0.f, 0.f, 0.f};
        u64 ssv[8];
#pragma unroll
        for (int rg = 0; rg < 8; ++rg) ssv[rg] = ss[row0 + (rg >> 2) * HALF + (rg & 3) * 16];
#pragma unroll
        for (int ai = 0; ai < 2; ++ai)
#pragma unroll
            for (int m = 0; m < 4; ++m) {
                const int row = row0 + ai * HALF + m * 16;
                const float rs = __builtin_amdgcn_rsqf(ss_dec(ssv[ai * 4 + m]) * (1.0f / DMODEL) + RMS_EPS);
                const float pos = (float)(row & (SEQ - 1));
#pragma unroll
                for (int bj = 0; bj < 2; ++bj) {
                    f32x4 v0 = acc[ai][bj][m][0] * rs, v1 = acc[ai][bj][m][1] * rs;
                    if (rot) {
#pragma unroll
                        for (int i = 0; i < 4; ++i) {
                            float rev = pos * invf[i]; rev = rev - __builtin_floorf(rev);
                            const float c = __builtin_amdgcn_cosf(rev), s = __builtin_amdgcn_sinf(rev);
                            const float a = v0[i], b = v1[i];
                            v0[i] = a * c - b * s; v1[i] = a * s + b * c;
                        }
                    }
                    if (t == 1) { csum[bj][0] += v0; csum[bj][1] += v1; }
                    v0 = v0 * qs; v1 = v1 * qs;
                    u32x2 w0, w1; w0.x = cvtpk(v0[0], v0[1]); w0.y = cvtpk(v0[2], v0[3]); w1.x = cvtpk(v1[0], v1[1]); w1.y = cvtpk(v1[2], v1[3]);
                    GAS bf16_t* p = O + (size_t)row * NQKV + col0 + bj * HALF;
                    *(GAS u32x2*)(p) = w0; *(GAS u32x2*)(p + 16) = w1;
                }
                asm volatile("" ::: "memory");
            }
        if (t == 1) {
#pragma unroll
            for (int bj = 0; bj < 2; ++bj)
#pragma unroll
                for (int n = 0; n < 2; ++n)
#pragma unroll
                    for (int i = 0; i < 4; ++i) {
                        float v = csum[bj][n][i];
                        v += __shfl_xor(v, 1); v += __shfl_xor(v, 2); v += __shfl_xor(v, 4); v += __shfl_xor(v, 8);
                        if (fr == 0) __hip_atomic_fetch_add(ksum + (size_t)u.pm * DMODEL + (u.pn - 8) * BM + bj * HALF + wc * 32 + n * 16 + 4 * fq + i, v, __ATOMIC_RELAXED, __HIP_MEMORY_SCOPE_AGENT);
                    }
        }
    }
};

struct EpiRIN {
    static constexpr bool PERM = true;
    GAS bf16_t* O; const GAS u64* ss;
    __device__ __forceinline__ void operator()(const f32x4 (&acc)[2][2][4][2], const Unit& u, int wr, int wc, int fr, int fq) const {
        const int row0 = u.pm * BM + wr * 64 + fr; const int col0 = u.pn * BM + wc * 32 + 8 * fq;
        const int t = u.pn >> 3;
        const float ks = (t == 1) ? 0.0625f : 1.0f;
        float invf[2][4];
#pragma unroll
        for (int n = 0; n < 2; ++n)
#pragma unroll
            for (int i = 0; i < 4; ++i) invf[n][i] = __builtin_amdgcn_exp2f(-(float)(wc * 32 + 8 * fq + 4 * n + i) * (13.287712379549449f / 127.0f)) * 0.15915494309189535f;
        u64 ssv[8];
#pragma unroll
        for (int rg = 0; rg < 8; ++rg) ssv[rg] = ss[row0 + (rg >> 2) * HALF + (rg & 3) * 16];
#pragma unroll
        for (int ai = 0; ai < 2; ++ai)
#pragma unroll
            for (int m = 0; m < 4; ++m) {
                const int row = row0 + ai * HALF + m * 16;
                const float rs = __builtin_amdgcn_rsqf(ss_dec(ssv[ai * 4 + m]) * (1.0f / DMODEL) + RMS_EPS);
                const float pos = (float)(row & (SEQ - 1));
                const float rsk = rs * ks;
                float v[2][8];
#pragma unroll
                for (int n = 0; n < 2; ++n)
#pragma unroll
                    for (int i = 0; i < 4; ++i) {
                        float a = acc[ai][0][m][n][i], b = acc[ai][1][m][n][i];
                        if (t < 2) {
                            float rev = pos * invf[n][i]; rev = rev - __builtin_floorf(rev);
                            const float c = __builtin_amdgcn_cosf(rev) * rsk, s = __builtin_amdgcn_sinf(rev) * rsk;
                            const float a2 = a * c - b * s, b2 = a * s + b * c; a = a2; b = b2;
                        } else if (t == 3) { a = silu_f(a * rs); b = silu_f(b * rs); }
                        else { a = a * rs; b = b * rs; }
                        v[0][4 * n + i] = a; v[1][4 * n + i] = b;
                    }
#pragma unroll
                for (int bj = 0; bj < 2; ++bj) {
                    u32x4 w; w.x = cvtpk(v[bj][0], v[bj][1]); w.y = cvtpk(v[bj][2], v[bj][3]); w.z = cvtpk(v[bj][4], v[bj][5]); w.w = cvtpk(v[bj][6], v[bj][7]);
                    *(GAS u32x4*)(O + (size_t)row * NRIN + col0 + bj * HALF) = w;
                }
                asm volatile("" ::: "memory");
            }
    }
};

template <class Epi, class Sched, bool ALIGN_EPI = false, bool SP2 = false>
__device__ __forceinline__ void gemm_phase(LAS unsigned char* lds, const Gemm g, const Sched& S, const Epi& E, const int tid) {
    const int wid = __builtin_amdgcn_readfirstlane(tid >> 6), lane = tid & 63, wr = wid >> 2, wc = wid & 3, fr = lane & 15, fq = lane >> 4;
    const int K = g.K, nt = K / BK;
    unsigned voffA[2], voffB[2];
#pragma unroll
    for (int i = 0; i < 2; ++i) { int R, C; stage_rc(tid * 16 + i * 8192, R, C); const int Rb = Epi::PERM ? ((R & ~31) + perm32(R & 31)) : R;
        voffA[i] = (unsigned)(R * K + C) * 2u; voffB[i] = (unsigned)(Rb * K + C) * 2u; }
    const size_t kstep = (size_t)(BK * 2);
    const size_t hstep = (size_t)HALF * K * 2;
    const size_t tstep = 2 * hstep;
    const unsigned ldsw = (unsigned)wid * 1024u;
    const int aoff = lds_byte(wr * 64 + fr, fq * 8), boff = lds_byte(wc * 32 + fr, fq * 8);
#define PG8_SA(b, h) (((b) * 2 + (h)) * HTB)
#define PG8_SB(b, h) ((4 + (b) * 2 + (h)) * HTB)
#define PG8_STAGE(bufoff, gbase, voff) do { _Pragma("unroll") for (int _i = 0; _i < 2; ++_i) \
        __builtin_amdgcn_global_load_lds((const unsigned*)((const GAS char*)(gbase) + (voff)[_i]), (LAS unsigned*)(lds + (bufoff) + ldsw + _i * 8192), 16, 0, 0); } while (0)
#define PG8_LDA(dst, b, h) do { _Pragma("unroll") for (int m = 0; m < 4; ++m) _Pragma("unroll") for (int k = 0; k < 2; ++k) dst[m][k] = *(const LAS bf16x8*)(lds + PG8_SA(b, h) + aoff + m * 2048 + k * 1024); } while (0)
#define PG8_LDB(dst, b, h) do { _Pragma("unroll") for (int n = 0; n < 2; ++n) _Pragma("unroll") for (int k = 0; k < 2; ++k) dst[n][k] = *(const LAS bf16x8*)(lds + PG8_SB(b, h) + boff + n * 2048 + k * 1024); } while (0)
#define PG8_MMA(ai, bj, At, Bt) do { __builtin_amdgcn_s_setprio(1); _Pragma("unroll") for (int k = 0; k < 2; ++k) _Pragma("unroll") for (int m = 0; m < 4; ++m) _Pragma("unroll") for (int n = 0; n < 2; ++n) \
        acc[ai][bj][m][n] = __builtin_amdgcn_mfma_f32_16x16x32_bf16(Bt[n][k], At[m][k], acc[ai][bj][m][n], 0, 0, 0); __builtin_amdgcn_s_setprio(0); } while (0)
#define PG8_WAIT_V(n) asm volatile("s_waitcnt vmcnt(" #n ")" ::: "memory")
#define PG8_WAIT_L(n) asm volatile("s_waitcnt lgkmcnt(" #n ")" ::: "memory")
#define PG8_BAR __builtin_amdgcn_s_barrier()
#define PG8_SCHED __builtin_amdgcn_sched_barrier(0)
    Unit cur, nxt; int ui = 0;
    if (!S.next(0, cur)) return;
    f32x4 acc[2][2][4][2];
#pragma unroll
    for (int a = 0; a < 2; ++a)
#pragma unroll
        for (int b = 0; b < 2; ++b)
#pragma unroll
            for (int m = 0; m < 4; ++m)
#pragma unroll
                for (int n = 0; n < 2; ++n) acc[a][b][m][n] = (f32x4){0.f, 0.f, 0.f, 0.f};
    bf16x8 At[4][2], B0[2][2], B1[2][2];
    const GAS char* cA = (const GAS char*)g.A + (size_t)cur.pm * tstep; const GAS char* cB = (const GAS char*)g.Bt + (size_t)cur.pn * tstep;
    if constexpr (SP2) {
        PG8_STAGE(PG8_SB(0, 0), cB, voffB); PG8_STAGE(PG8_SB(0, 1), cB + hstep, voffB); PG8_STAGE(PG8_SA(0, 0), cA, voffA); PG8_STAGE(PG8_SA(0, 1), cA + hstep, voffA);
        if (wr == 1) PG8_BAR;
        PG8_WAIT_V(2); PG8_BAR;
        PG8_STAGE(PG8_SB(1, 0), cB + kstep, voffB); PG8_STAGE(PG8_SA(1, 0), cA + kstep, voffA); PG8_STAGE(PG8_SB(1, 1), cB + hstep + kstep, voffB);
        PG8_WAIT_V(6); PG8_BAR;
    } else {
        PG8_STAGE(PG8_SB(0, 0), cB, voffB); PG8_STAGE(PG8_SA(0, 0), cA, voffA); PG8_STAGE(PG8_SB(0, 1), cB + hstep, voffB); PG8_STAGE(PG8_SA(0, 1), cA + hstep, voffA);
        if (wr == 1) PG8_BAR;
        PG8_WAIT_V(4); PG8_BAR;
        PG8_STAGE(PG8_SB(1, 0), cB + kstep, voffB); PG8_STAGE(PG8_SA(1, 0), cA + kstep, voffA); PG8_STAGE(PG8_SB(1, 1), cB + hstep + kstep, voffB);
        PG8_WAIT_V(6); PG8_BAR;
    }
    for (;;) {
        const bool has_next = S.next(ui + 1, nxt);
        const GAS char* nA = has_next ? (const GAS char*)g.A + (size_t)nxt.pm * tstep : cA; const GAS char* nB = has_next ? (const GAS char*)g.Bt + (size_t)nxt.pn * tstep : cB;
        for (int t = 0; t < nt; t += 2) {
            const bool last = (t == nt - 2);
            const GAS char* a1 = cA + (size_t)(t + 1) * kstep;
            const GAS char* a2 = last ? nA : cA + (size_t)(t + 2) * kstep; const GAS char* b2 = last ? nB : cB + (size_t)(t + 2) * kstep;
            const GAS char* a3 = a2 + kstep; const GAS char* b3 = b2 + kstep;
            if constexpr (SP2) {
            PG8_LDB(B0, 0, 0); PG8_LDB(B1, 0, 1); PG8_SCHED; PG8_LDA(At, 0, 0); PG8_STAGE(PG8_SA(1, 1), a1 + hstep, voffA);
            PG8_WAIT_V(8); PG8_WAIT_L(0); PG8_BAR; PG8_MMA(0, 0, At, B0); PG8_MMA(0, 1, At, B1); PG8_BAR; PG8_SCHED;
            PG8_LDA(At, 0, 1); PG8_STAGE(PG8_SB(0, 0), b2, voffB); PG8_STAGE(PG8_SB(0, 1), b2 + hstep, voffB); PG8_STAGE(PG8_SA(0, 0), a2, voffA);
            PG8_WAIT_V(8); PG8_WAIT_L(0); PG8_BAR; PG8_MMA(1, 0, At, B0); PG8_MMA(1, 1, At, B1); PG8_BAR; PG8_SCHED;
            PG8_LDB(B0, 1, 0); PG8_LDB(B1, 1, 1); PG8_SCHED; PG8_LDA(At, 1, 0); PG8_STAGE(PG8_SA(0, 1), a2 + hstep, voffA);
            PG8_WAIT_V(8); PG8_WAIT_L(0); PG8_BAR; PG8_MMA(0, 0, At, B0); PG8_MMA(0, 1, At, B1); PG8_BAR; PG8_SCHED;
            PG8_LDA(At, 1, 1); PG8_STAGE(PG8_SB(1, 0), b3, voffB); PG8_STAGE(PG8_SB(1, 1), b3 + hstep, voffB); PG8_STAGE(PG8_SA(1, 0), a3, voffA);
            PG8_WAIT_V(8); PG8_WAIT_L(0); PG8_BAR; PG8_MMA(1, 0, At, B0); PG8_MMA(1, 1, At, B1); PG8_BAR; PG8_SCHED;
            } else {
            PG8_LDB(B0, 0, 0); PG8_SCHED; PG8_LDA(At, 0, 0); PG8_STAGE(PG8_SA(1, 1), a1 + hstep, voffA);
            PG8_WAIT_L(8); PG8_BAR; PG8_WAIT_L(0); PG8_MMA(0, 0, At, B0); PG8_BAR; PG8_SCHED;
            PG8_LDB(B1, 0, 1); PG8_STAGE(PG8_SB(0, 0), b2, voffB);
            PG8_BAR; PG8_WAIT_L(0); PG8_MMA(0, 1, At, B1); PG8_BAR;
            PG8_LDA(At, 0, 1); PG8_STAGE(PG8_SA(0, 0), a2, voffA);
            PG8_BAR; PG8_WAIT_L(0); PG8_MMA(1, 0, At, B0); PG8_BAR; PG8_SCHED;
            PG8_STAGE(PG8_SB(0, 1), b2 + hstep, voffB);
            PG8_WAIT_V(6); PG8_BAR; PG8_MMA(1, 1, At, B1); PG8_BAR;
            PG8_LDB(B0, 1, 0); PG8_SCHED; PG8_LDA(At, 1, 0); PG8_STAGE(PG8_SA(0, 1), a2 + hstep, voffA);
            PG8_WAIT_L(8); PG8_BAR; PG8_WAIT_L(0); PG8_MMA(0, 0, At, B0); PG8_BAR; PG8_SCHED;
            PG8_LDB(B1, 1, 1); PG8_STAGE(PG8_SB(1, 0), b3, voffB);
            PG8_BAR; PG8_WAIT_L(0); PG8_MMA(0, 1, At, B1); PG8_BAR;
            PG8_LDA(At, 1, 1); PG8_STAGE(PG8_SA(1, 0), a3, voffA);
            PG8_BAR; PG8_WAIT_L(0); PG8_MMA(1, 0, At, B0); PG8_BAR; PG8_SCHED;
            PG8_STAGE(PG8_SB(1, 1), b3 + hstep, voffB);
            PG8_WAIT_V(6); PG8_BAR; PG8_MMA(1, 1, At, B1); PG8_BAR;
            }
        }
        if constexpr (ALIGN_EPI) { if (wr == 0) PG8_BAR; }
        E(acc, cur, wr, wc, fr, fq);
        if (!has_next) break;
#pragma unroll
        for (int a = 0; a < 2; ++a)
#pragma unroll
            for (int b = 0; b < 2; ++b)
#pragma unroll
                for (int m = 0; m < 4; ++m)
#pragma unroll
                    for (int n = 0; n < 2; ++n) acc[a][b][m][n] = (f32x4){0.f, 0.f, 0.f, 0.f};
        cur = nxt; cA = nA; cB = nB; ++ui;
        if constexpr (ALIGN_EPI) { if (wr == 1) PG8_BAR; }
    }
    PG8_WAIT_V(0);
    if constexpr (!ALIGN_EPI) { if (wr == 0) PG8_BAR; }
    PG8_BAR;
#undef PG8_SA
#undef PG8_SB
#undef PG8_STAGE
#undef PG8_LDA
#undef PG8_LDB
#undef PG8_MMA
#undef PG8_WAIT_V
#undef PG8_WAIT_L
#undef PG8_BAR
#undef PG8_SCHED
}
}

template <int DK, int DV, bool MOBA>
__device__ __forceinline__ void attn_unit(LAS unsigned char* lds, const GAS bf16_t* Qb, const GAS bf16_t* Kb, const GAS bf16_t* Vb, int ld, int q0, GAS bf16_t* Out,
                                          const GAS float* ksum  , float lg2  ,
                                          const GAS bf16_t* SGb  , const GAS float* gn  , const int tid) {
    constexpr int KRS = DK * 2 + 16, VRS = DV * 2 + 32;
    constexpr int OFF_K = 0, OFF_V = 2 * 64 * KRS, OFF_MISC = OFF_V + 2 * 64 * VRS;
    constexpr int KCPR = DK / 8, KCH = 64 * KCPR / NTHREADS, VCPR = DV / 8, VCH = 64 * VCPR / NTHREADS;
    static_assert(OFF_MISC + 4096 <= LDS_BYTES, "attention LDS");
    int tl = tid; asm volatile("" : "+v"(tl));
    const int lane = tl & 63, w = __builtin_amdgcn_readfirstlane(tl >> 6), lq = lane & 15, g = lane >> 4;
    const int qpos = q0 + 16 * w + lq;
    const int qb = q0 >> 8;
    unsigned selmask = 0;
    int ntown, nt;
    if constexpr (MOBA) {
        LAS float* km = (LAS float*)(lds + OFF_MISC);
        for (int idx = tid; idx < qb * 128; idx += NTHREADS) km[idx] = ksum[(size_t)(idx >> 7) * DMODEL + (idx & 127)];
        __syncthreads();
        float g0 = 0.f, g1 = 0.f;
        const GAS bf16_t* qrow = Qb + (size_t)qpos * ld;
#pragma unroll 4
        for (int c = 0; c < 16; ++c) {
            const u32x4 qq = *(const GAS u32x4*)(qrow + 8 * c);
#pragma unroll
            for (int e = 0; e < 4; ++e) {
                const float lo = __builtin_bit_cast(float, qq[e] << 16), hi = __builtin_bit_cast(float, qq[e] & 0xffff0000u);
                g0 += lo * km[g * 128 + 8 * c + 2 * e] + hi * km[g * 128 + 8 * c + 2 * e + 1];
                g1 += lo * km[(g + 4) * 128 + 8 * c + 2 * e] + hi * km[(g + 4) * 128 + 8 * c + 2 * e + 1];
            }
        }
        float gt[8];
#pragma unroll
        for (int j = 0; j < 8; ++j) gt[j] = __shfl(j < 4 ? g0 : g1, lq + 16 * (j & 3));
#pragma unroll
        for (int j = 0; j < 8; ++j) {
            int cnt = 0;
#pragma unroll
            for (int j2 = 0; j2 < 8; ++j2) if (j2 != j) cnt += (j2 < qb && (gt[j2] > gt[j] || (gt[j2] == gt[j] && j2 < j))) ? 1 : 0;
            if (j < qb && cnt < 3) selmask |= 1u << j;
        }
        ntown = ((q0 & 255) + 128) >> 6;
        nt = ntown + 4 * qb;
    } else {
        ntown = 0; nt = (q0 + 128) >> 6;
    }
    bf16x8 qf[DK / 32];
    {
        const GAS bf16_t* qrow = Qb + (size_t)qpos * ld + 8 * g;
#pragma unroll
        for (int ks = 0; ks < DK / 32; ++ks) qf[ks] = *(const GAS bf16x8*)(qrow + 32 * ks);
    }
    f32x4 o[DV / 16];
#pragma unroll
    for (int dt = 0; dt < DV / 16; ++dt) o[dt] = (f32x4){0.f, 0.f, 0.f, 0.f};
    float mrow = -1e30f, lsum = 0.f;
    float dc1[4], dc2[4];
#pragma unroll
    for (int i = 0; i < 4; ++i) {
        dc1[i] = MOBA ? 1.f : __builtin_bit_cast(float, __builtin_amdgcn_readfirstlane(__builtin_bit_cast(int, __builtin_amdgcn_exp2f(-lg2 * (float)(16 * i)))));
        dc2[i] = MOBA ? 1.f : __builtin_bit_cast(float, __builtin_amdgcn_readfirstlane(__builtin_bit_cast(int, __builtin_amdgcn_exp2f(-lg2 * (float)i))));
    }
    u32x4 kreg[KCH], vreg[VCH];
#define ATT_KEY0(ti) (MOBA ? ((ti) < ntown ? (qb * 256 + 64 * (ti)) : 64 * ((ti) - ntown)) : 64 * (ti))
#define ATT_GLOADK(key0) do { int tq = tid; asm volatile("" : "+v"(tq)); \
        _Pragma("unroll") for (int j = 0; j < KCH; ++j) { const unsigned cidx = (unsigned)tq + NTHREADS * j; kreg[j] = *(const GAS u32x4*)(Kb + (size_t)((key0) + cidx / KCPR) * ld + (cidx % KCPR) * 8); } } while (0)
#define ATT_GLOADV(key0) do { int tq = tid; asm volatile("" : "+v"(tq)); \
        _Pragma("unroll") for (int j = 0; j < VCH; ++j) { const unsigned cidx = (unsigned)tq + NTHREADS * j; vreg[j] = *(const GAS u32x4*)(Vb + (size_t)((key0) + cidx / VCPR) * ld + (cidx % VCPR) * 8); } } while (0)
#define ATT_LWRITEK(buf) do { int tq = tid; asm volatile("" : "+v"(tq)); \
        _Pragma("unroll") for (int j = 0; j < KCH; ++j) { const unsigned cidx = (unsigned)tq + NTHREADS * j; *(LAS u32x4*)(lds + OFF_K + (buf) * 64 * KRS + (cidx / KCPR) * KRS + (cidx % KCPR) * 16) = kreg[j]; } } while (0)
#define ATT_LWRITEV(buf) do { int tq = tid; asm volatile("" : "+v"(tq)); \
        _Pragma("unroll") for (int j = 0; j < VCH; ++j) { const unsigned cidx = (unsigned)tq + NTHREADS * j; *(LAS u32x4*)(lds + OFF_V + (buf) * 64 * VRS + (cidx / VCPR) * VRS + (cidx % VCPR) * 16) = vreg[j]; } } while (0)
    ATT_GLOADK(ATT_KEY0(0));
    ATT_LWRITEK(0);
    ATT_GLOADV(ATT_KEY0(0));
    ATT_LWRITEV(0);
    __syncthreads();
    for (int ti = 0; ti < nt; ++ti) {
        const int buf = ti & 1;
        const int key0 = ATT_KEY0(ti);
        const int nk0 = ATT_KEY0(ti + 1);
        if (ti + 1 < nt) { ATT_GLOADK(nk0); ATT_GLOADV(nk0); }
        bool active;
        const bool diag = MOBA ? (ti < ntown) : (key0 + 63 > q0);
        if constexpr (MOBA) {
            if (ti < ntown) active = (key0 <= q0 + 16 * w + 15);
            else active = __any((selmask >> ((ti - ntown) >> 2)) & 1u) != 0;
        } else active = (key0 <= q0 + 16 * w + 15);
        if (active) {
            f32x4 s[4];
#pragma unroll
            for (int kt = 0; kt < 4; ++kt) s[kt] = (f32x4){0.f, 0.f, 0.f, 0.f};
            const LAS unsigned char* kbase = lds + OFF_K + buf * 64 * KRS + lq * KRS + g * 16;
            bf16x8 kfa[4], kfb[4];
#pragma unroll
            for (int kt = 0; kt < 4; ++kt) kfa[kt] = *(const LAS bf16x8*)(kbase + kt * 16 * KRS);
#pragma unroll
            for (int ks = 0; ks < DK / 32; ks += 2) {
#pragma unroll
                for (int kt = 0; kt < 4; ++kt) kfb[kt] = *(const LAS bf16x8*)(kbase + kt * 16 * KRS + (ks + 1) * 64);
#pragma unroll
                for (int kt = 0; kt < 4; ++kt) s[kt] = __builtin_amdgcn_mfma_f32_16x16x32_bf16(kfa[kt], qf[ks], s[kt], 0, 0, 0);
                __builtin_amdgcn_sched_barrier(0);
                if (ks + 2 < DK / 32) {
#pragma unroll
                    for (int kt = 0; kt < 4; ++kt) kfa[kt] = *(const LAS bf16x8*)(kbase + kt * 16 * KRS + (ks + 2) * 64);
                }
#pragma unroll
                for (int kt = 0; kt < 4; ++kt) s[kt] = __builtin_amdgcn_mfma_f32_16x16x32_bf16(kfb[kt], qf[ks + 1], s[kt], 0, 0, 0);
                __builtin_amdgcn_sched_barrier(0);
            }
            unsigned pk[4][2];
            if constexpr (MOBA) {
                const float NEG = -INFINITY;
                if (diag) {
#pragma unroll
                    for (int kt = 0; kt < 4; ++kt)
#pragma unroll
                        for (int r = 0; r < 4; ++r) if (key0 + 16 * kt + 4 * g + r > qpos) s[kt][r] = NEG;
                } else if (!((selmask >> ((ti - ntown) >> 2)) & 1u)) {
#pragma unroll
                    for (int kt = 0; kt < 4; ++kt) s[kt] = (f32x4){NEG, NEG, NEG, NEG};
                }
                float mx = NEG;
#pragma unroll
                for (int kt = 0; kt < 4; ++kt) mx = fmaxf(mx, fmaxf(fmaxf(s[kt][0], s[kt][1]), fmaxf(s[kt][2], s[kt][3])));
                mx = fmaxf(mx, __shfl_xor(mx, 16)); mx = fmaxf(mx, __shfl_xor(mx, 32));
                const float mnew = fmaxf(mrow, mx);
                const float alpha = __builtin_amdgcn_exp2f(mrow - mnew);
                mrow = mnew;
                float ps = 0.f;
#pragma unroll
                for (int kt = 0; kt < 4; ++kt) {
#pragma unroll
                    for (int r = 0; r < 4; ++r) { s[kt][r] = __builtin_amdgcn_exp2f(s[kt][r] - mnew); ps += s[kt][r]; }
                    pk[kt][0] = cvtpk(s[kt][0], s[kt][1]); pk[kt][1] = cvtpk(s[kt][2], s[kt][3]);
                }
                lsum = lsum * alpha + ps;
#pragma unroll
                for (int dt = 0; dt < DV / 16; ++dt) o[dt] = o[dt] * alpha;
            } else if (diag) {
#pragma unroll
                for (int kt = 0; kt < 4; ++kt) {
#pragma unroll
                    for (int r = 0; r < 4; ++r) {
                        const int dist = qpos - (key0 + 16 * kt + 4 * g + r);
                        const float dec = __builtin_amdgcn_exp2f((float)dist * lg2);
                        s[kt][r] = (dist >= 0) ? s[kt][r] * dec : 0.f;
                    }
                    pk[kt][0] = cvtpk(s[kt][0], s[kt][1]); pk[kt][1] = cvtpk(s[kt][2], s[kt][3]);
                }
            } else {
                const float rowf = __builtin_amdgcn_exp2f((float)(qpos - key0 - 4 * g) * lg2);
#pragma unroll
                for (int kt = 0; kt < 4; ++kt) {
                    const float rk = rowf * dc1[kt];
#pragma unroll
                    for (int r = 0; r < 4; ++r) s[kt][r] = s[kt][r] * (rk * dc2[r]);
                    pk[kt][0] = cvtpk(s[kt][0], s[kt][1]); pk[kt][1] = cvtpk(s[kt][2], s[kt][3]);
                }
            }
            const LAS unsigned char* vbase = lds + OFF_V + buf * 64 * VRS + (4 * g + (lq >> 2)) * VRS + (lane & 3) * 8;
            {
                constexpr int GPS = DV / 64, NG = 2 * GPS;
                bf16x8 pf[2];
#pragma unroll
                for (int s2 = 0; s2 < 2; ++s2) { const u32x4 pw = (u32x4){pk[2 * s2][0], pk[2 * s2][1], pk[2 * s2 + 1][0], pk[2 * s2 + 1][1]}; pf[s2] = __builtin_bit_cast(bf16x8, pw); }
                bf16x8 vfa[4], vfb[4];
#define ATT_LOADV(dst, gi) do { _Pragma("unroll") for (int j = 0; j < 4; ++j) { const int dt_ = ((gi) % GPS) * 4 + j; \
                    const s16x4 v0 = __builtin_amdgcn_ds_read_tr16_b64_v4i16((LAS s16x4*)(vbase + (32 * ((gi) / GPS)) * VRS + dt_ * 32)); \
                    const s16x4 v1 = __builtin_amdgcn_ds_read_tr16_b64_v4i16((LAS s16x4*)(vbase + (32 * ((gi) / GPS) + 16) * VRS + dt_ * 32)); \
                    dst[j] = (bf16x8){v0[0], v0[1], v0[2], v0[3], v1[0], v1[1], v1[2], v1[3]}; } } while (0)
#define ATT_MMAV(src, gi) do { _Pragma("unroll") for (int j = 0; j < 4; ++j) { const int dt_ = ((gi) % GPS) * 4 + j; o[dt_] = __builtin_amdgcn_mfma_f32_16x16x32_bf16(src[j], pf[(gi) / GPS], o[dt_], 0, 0, 0); } } while (0)
                ATT_LOADV(vfa, 0);
#pragma unroll
                for (int gi = 0; gi < NG; gi += 2) {
                    ATT_LOADV(vfb, gi + 1);
                    ATT_MMAV(vfa, gi);
                    __builtin_amdgcn_sched_barrier(0);
                    if (gi + 2 < NG) ATT_LOADV(vfa, gi + 2);
                    ATT_MMAV(vfb, gi + 1);
                    __builtin_amdgcn_sched_barrier(0);
                }
#undef ATT_LOADV
#undef ATT_MMAV
            }
        }
        if (ti + 1 < nt) { ATT_LWRITEK(buf ^ 1); ATT_LWRITEV(buf ^ 1); }
        __syncthreads();
    }
#undef ATT_KEY0
#undef ATT_GLOADK
#undef ATT_GLOADV
#undef ATT_LWRITEK
#undef ATT_LWRITEV
    int te = tid; asm volatile("" : "+v"(te));
    const int g_e = (te & 63) >> 4, qpos_e = q0 + 16 * (te >> 6) + (te & 15);
    if constexpr (MOBA) {
        float l = lsum; l += __shfl_xor(l, 16); l += __shfl_xor(l, 32);
        const float inv = __builtin_amdgcn_rcpf(l);
        GAS bf16_t* orow = Out + (size_t)qpos_e * DMODEL + 4 * g_e;
#pragma unroll
        for (int dt = 0; dt < DV / 16; ++dt) { u32x2 wv; wv.x = cvtpk(o[dt][0] * inv, o[dt][1] * inv); wv.y = cvtpk(o[dt][2] * inv, o[dt][3] * inv); *(GAS u32x2*)(orow + 16 * dt) = wv; }
    } else {
        float s2 = 0.f;
#pragma unroll
        for (int dt = 0; dt < DV / 16; ++dt) s2 += (o[dt][0] * o[dt][0] + o[dt][1] * o[dt][1]) + (o[dt][2] * o[dt][2] + o[dt][3] * o[dt][3]);
        s2 += __shfl_xor(s2, 16); s2 += __shfl_xor(s2, 32);
        const float rs = __builtin_amdgcn_rsqf(s2 * (1.0f / DV) + RMS_EPS);
        GAS bf16_t* orow = Out + (size_t)qpos_e * DMODEL + 4 * g_e;
        const GAS bf16_t* sgrow = SGb + (size_t)qpos_e * ld + 4 * g_e;
#pragma unroll
        for (int dt = 0; dt < DV / 16; ++dt) {
            const u32x2 sg = *(const GAS u32x2*)(sgrow + 16 * dt);
            const f32x4 gg = *(const GAS f32x4*)(gn + 16 * dt + 4 * g_e);
            const float y0 = o[dt][0] * rs * gg[0] * __builtin_bit_cast(float, sg.x << 16), y1 = o[dt][1] * rs * gg[1] * __builtin_bit_cast(float, sg.x & 0xffff0000u);
            const float y2 = o[dt][2] * rs * gg[2] * __builtin_bit_cast(float, sg.y << 16), y3 = o[dt][3] * rs * gg[3] * __builtin_bit_cast(float, sg.y & 0xffff0000u);
            u32x2 wv; wv.x = cvtpk(y0, y1); wv.y = cvtpk(y2, y3); *(GAS u32x2*)(orow + 16 * dt) = wv;
        }
    }
}

__device__ __forceinline__ void moba_unit256(LAS unsigned char* lds, const GAS bf16_t* Qb, const GAS bf16_t* Kb, const GAS bf16_t* Vb, const int qb, GAS bf16_t* Out, const GAS float* ksum, const int tid) {
    constexpr int DK = 128, DV = 128, ld = NQKV;
    constexpr int KRS = DK * 2 + 16, VRS = DV * 2 + 32;
    constexpr int OFF_K = 0, OFF_V = 2 * 64 * KRS, OFF_MISC = OFF_V + 2 * 64 * VRS;
    constexpr int KCPR = DK / 8, KCH = 64 * KCPR / NTHREADS, VCPR = DV / 8, VCH = 64 * VCPR / NTHREADS;
    int tl = tid; asm volatile("" : "+v"(tl));
    const int lane = tl & 63, w = __builtin_amdgcn_readfirstlane(tl >> 6), lq = lane & 15, g = lane >> 4;
    const int q0 = qb * 256;
    int qpos[2]; qpos[0] = q0 + 32 * w + lq; qpos[1] = qpos[0] + 16;
    unsigned selmask[2] = {0u, 0u};
    {
        LAS float* km = (LAS float*)(lds + OFF_MISC);
        for (int idx = tid; idx < qb * 128; idx += NTHREADS) km[idx] = ksum[(size_t)(idx >> 7) * DMODEL + (idx & 127)];
        __syncthreads();
#pragma unroll
        for (int st = 0; st < 2; ++st) {
            float g0 = 0.f, g1 = 0.f;
            const GAS bf16_t* qrow = Qb + (size_t)qpos[st] * ld;
#pragma unroll 4
            for (int c = 0; c < 16; ++c) {
                const u32x4 qq = *(const GAS u32x4*)(qrow + 8 * c);
#pragma unroll
                for (int e = 0; e < 4; ++e) {
                    const float lo = __builtin_bit_cast(float, qq[e] << 16), hi = __builtin_bit_cast(float, qq[e] & 0xffff0000u);
                    g0 += lo * km[g * 128 + 8 * c + 2 * e] + hi * km[g * 128 + 8 * c + 2 * e + 1];
                    g1 += lo * km[(g + 4) * 128 + 8 * c + 2 * e] + hi * km[(g + 4) * 128 + 8 * c + 2 * e + 1];
                }
            }
            float gt[8];
#pragma unroll
            for (int j = 0; j < 8; ++j) { const float v = __shfl(j < 4 ? g0 : g1, lq + 16 * (j & 3)); gt[j] = (j < qb) ? v : -INFINITY; }
            unsigned sm = 0u;
#pragma unroll
            for (int j = 0; j < 8; ++j) {
                int cnt = 0;
#pragma unroll
                for (int j2 = 0; j2 < 8; ++j2) if (j2 != j) cnt += (int)((j2 < j) ? (gt[j2] >= gt[j]) : (gt[j2] > gt[j]));
                sm |= (cnt < 3) ? (1u << j) : 0u;
            }
            selmask[st] = sm & ((1u << qb) - 1u);
        }
    }
    const int nt = 4 + 4 * qb;
    bf16x8 qf[2][DK / 32];
#pragma unroll
    for (int st = 0; st < 2; ++st) {
        const GAS bf16_t* qrow = Qb + (size_t)qpos[st] * ld + 8 * g;
#pragma unroll
        for (int ks = 0; ks < DK / 32; ++ks) qf[st][ks] = *(const GAS bf16x8*)(qrow + 32 * ks);
    }
    f32x4 o[2][DV / 16];
#pragma unroll
    for (int st = 0; st < 2; ++st)
#pragma unroll
        for (int dt = 0; dt < DV / 16; ++dt) o[st][dt] = (f32x4){0.f, 0.f, 0.f, 0.f};
    float mrow[2] = {-1e30f, -1e30f}, lsum[2] = {0.f, 0.f};
    u32x4 kreg[KCH], vreg[VCH];
#define MB_KEY0(ti) ((ti) < 4 ? (q0 + 64 * (ti)) : 64 * ((ti) - 4))
#define MB_GLOAD(key0) do { int tq = tid; asm volatile("" : "+v"(tq)); \
        _Pragma("unroll") for (int j = 0; j < KCH; ++j) { const unsigned cidx = (unsigned)tq + NTHREADS * j; kreg[j] = *(const GAS u32x4*)(Kb + (size_t)((key0) + cidx / KCPR) * ld + (cidx % KCPR) * 8); } \
        _Pragma("unroll") for (int j = 0; j < VCH; ++j) { const unsigned cidx = (unsigned)tq + NTHREADS * j; vreg[j] = *(const GAS u32x4*)(Vb + (size_t)((key0) + cidx / VCPR) * ld + (cidx % VCPR) * 8); } } while (0)
#define MB_LWRITE(buf) do { int tq = tid; asm volatile("" : "+v"(tq)); \
        _Pragma("unroll") for (int j = 0; j < KCH; ++j) { const unsigned cidx = (unsigned)tq + NTHREADS * j; *(LAS u32x4*)(lds + OFF_K + (buf) * 64 * KRS + (cidx / KCPR) * KRS + (cidx % KCPR) * 16) = kreg[j]; } \
        _Pragma("unroll") for (int j = 0; j < VCH; ++j) { const unsigned cidx = (unsigned)tq + NTHREADS * j; *(LAS u32x4*)(lds + OFF_V + (buf) * 64 * VRS + (cidx / VCPR) * VRS + (cidx % VCPR) * 16) = vreg[j]; } } while (0)
    MB_GLOAD(MB_KEY0(0));
    MB_LWRITE(0);
    __syncthreads();
    for (int ti = 0; ti < nt; ++ti) {
        const int buf = ti & 1;
        const int key0 = MB_KEY0(ti);
        const int nk0 = MB_KEY0(ti + 1);
        if (ti + 1 < nt) MB_GLOAD(nk0);
        const bool diag = ti < 4;
        const unsigned bit = diag ? 0u : (1u << ((ti - 4) >> 2));
        bool active;
        if (diag) active = (64 * ti <= 32 * w + 31);
        else active = __any(((selmask[0] | selmask[1]) & bit) != 0u) != 0;
        if (active) {
            f32x4 s[2][4];
#pragma unroll
            for (int st = 0; st < 2; ++st)
#pragma unroll
                for (int kt = 0; kt < 4; ++kt) s[st][kt] = (f32x4){0.f, 0.f, 0.f, 0.f};
            const LAS unsigned char* kbase = lds + OFF_K + buf * 64 * KRS + lq * KRS + g * 16;
#pragma unroll
            for (int ks = 0; ks < DK / 32; ++ks)
#pragma unroll
                for (int kt = 0; kt < 4; ++kt) {
                    const bf16x8 kf = *(const LAS bf16x8*)(kbase + kt * 16 * KRS + ks * 64);
                    s[0][kt] = __builtin_amdgcn_mfma_f32_16x16x32_bf16(kf, qf[0][ks], s[0][kt], 0, 0, 0);
                    s[1][kt] = __builtin_amdgcn_mfma_f32_16x16x32_bf16(kf, qf[1][ks], s[1][kt], 0, 0, 0);
                }
            unsigned pk[2][4][2];
            const float NEG = -INFINITY;
#pragma unroll
            for (int st = 0; st < 2; ++st) {
                if (diag) {
#pragma unroll
                    for (int kt = 0; kt < 4; ++kt)
#pragma unroll
                        for (int r = 0; r < 4; ++r) if (key0 + 16 * kt + 4 * g + r > qpos[st]) s[st][kt][r] = NEG;
                } else if (!(selmask[st] & bit)) {
#pragma unroll
                    for (int kt = 0; kt < 4; ++kt) s[st][kt] = (f32x4){NEG, NEG, NEG, NEG};
                }
                float mx = NEG;
#pragma unroll
                for (int kt = 0; kt < 4; ++kt) mx = fmaxf(mx, fmaxf(fmaxf(s[st][kt][0], s[st][kt][1]), fmaxf(s[st][kt][2], s[st][kt][3])));
                mx = fmaxf(mx, __shfl_xor(mx, 16)); mx = fmaxf(mx, __shfl_xor(mx, 32));
                const float mnew = fmaxf(mrow[st], mx);
                const float alpha = __builtin_amdgcn_exp2f(mrow[st] - mnew);
                mrow[st] = mnew;
                float ps = 0.f;
#pragma unroll
                for (int kt = 0; kt < 4; ++kt) {
#pragma unroll
                    for (int r = 0; r < 4; ++r) { s[st][kt][r] = __builtin_amdgcn_exp2f(s[st][kt][r] - mnew); ps += s[st][kt][r]; }
                    pk[st][kt][0] = cvtpk(s[st][kt][0], s[st][kt][1]); pk[st][kt][1] = cvtpk(s[st][kt][2], s[st][kt][3]);
                }
                lsum[st] = lsum[st] * alpha + ps;
#pragma unroll
                for (int dt = 0; dt < DV / 16; ++dt) o[st][dt] = o[st][dt] * alpha;
            }
            const LAS unsigned char* vbase = lds + OFF_V + buf * 64 * VRS + (4 * g + (lq >> 2)) * VRS + (lane & 3) * 8;
            {
                constexpr int GPS = DV / 64, NG = 2 * GPS;
                bf16x8 pf[2][2];
#pragma unroll
                for (int st = 0; st < 2; ++st)
#pragma unroll
                    for (int s2 = 0; s2 < 2; ++s2) { const u32x4 pw = (u32x4){pk[st][2 * s2][0], pk[st][2 * s2][1], pk[st][2 * s2 + 1][0], pk[st][2 * s2 + 1][1]}; pf[st][s2] = __builtin_bit_cast(bf16x8, pw); }
                bf16x8 vfa[4], vfb[4];
#define MB_LOADV(dst, gi) do { _Pragma("unroll") for (int j = 0; j < 4; ++j) { const int dt_ = ((gi) % GPS) * 4 + j; \
                    const s16x4 v0 = __builtin_amdgcn_ds_read_tr16_b64_v4i16((LAS s16x4*)(vbase + (32 * ((gi) / GPS)) * VRS + dt_ * 32)); \
                    const s16x4 v1 = __builtin_amdgcn_ds_read_tr16_b64_v4i16((LAS s16x4*)(vbase + (32 * ((gi) / GPS) + 16) * VRS + dt_ * 32)); \
                    dst[j] = (bf16x8){v0[0], v0[1], v0[2], v0[3], v1[0], v1[1], v1[2], v1[3]}; } } while (0)
#define MB_MMAV(src, gi) do { _Pragma("unroll") for (int j = 0; j < 4; ++j) { const int dt_ = ((gi) % GPS) * 4 + j; \
                    o[0][dt_] = __builtin_amdgcn_mfma_f32_16x16x32_bf16(src[j], pf[0][(gi) / GPS], o[0][dt_], 0, 0, 0); \
                    o[1][dt_] = __builtin_amdgcn_mfma_f32_16x16x32_bf16(src[j], pf[1][(gi) / GPS], o[1][dt_], 0, 0, 0); } } while (0)
                MB_LOADV(vfa, 0);
#pragma unroll
                for (int gi = 0; gi < NG; gi += 2) {
                    MB_LOADV(vfb, gi + 1);
                    MB_MMAV(vfa, gi);
                    __builtin_amdgcn_sched_barrier(0);
                    if (gi + 2 < NG) MB_LOADV(vfa, gi + 2);
                    MB_MMAV(vfb, gi + 1);
                    __builtin_amdgcn_sched_barrier(0);
                }
#undef MB_LOADV
#undef MB_MMAV
            }
        }
        if (ti + 1 < nt) MB_LWRITE(buf ^ 1);
        __syncthreads();
    }
#undef MB_KEY0
#undef MB_GLOAD
#undef MB_LWRITE
    int te = tid; asm volatile("" : "+v"(te));
    const int g_e = (te & 63) >> 4;
#pragma unroll
    for (int st = 0; st < 2; ++st) {
        const int qpos_e = q0 + 32 * (te >> 6) + 16 * st + (te & 15);
        float l = lsum[st]; l += __shfl_xor(l, 16); l += __shfl_xor(l, 32);
        const float inv = __builtin_amdgcn_rcpf(l);
        GAS bf16_t* orow = Out + (size_t)qpos_e * DMODEL + 4 * g_e;
#pragma unroll
        for (int dt = 0; dt < DV / 16; ++dt) { u32x2 wv; wv.x = cvtpk(o[st][dt][0] * inv, o[st][dt][1] * inv); wv.y = cvtpk(o[st][dt][2] * inv, o[st][dt][3] * inv); *(GAS u32x2*)(orow + 16 * dt) = wv; }
    }
}

__device__ __forceinline__ void xpose_item(const GAS float* __restrict__ W, int K, int N, GAS bf16_t* __restrict__ dst, const GAS float* __restrict__ gain, int src_n0, int dst_n0, int k0,
                                           LAS unsigned char* scr, int lane) {
    constexpr int RS = 260;
#pragma unroll 16
    for (int i = 0; i < 32; ++i) {
        const int kk = 2 * i + (lane >> 5);
        f32x4 v = __builtin_nontemporal_load((const GAS f32x4*)(W + (size_t)(k0 + kk) * N + src_n0 + 4 * (lane & 31)));
        const float gg = gain ? gain[k0 + kk] : 1.0f;
        v = v * gg;
        LAS unsigned* p = (LAS unsigned*)(scr + kk * RS + 8 * (lane & 31));
        p[0] = cvtpk(v[0], v[1]); p[1] = cvtpk(v[2], v[3]);
    }
    asm volatile("s_waitcnt lgkmcnt(0)" ::: "memory");
    const int c = lane & 7, r = lane >> 3;
#pragma unroll 4
    for (int j = 0; j < 16; ++j) {
        const int nn = r + 8 * j;
        const LAS unsigned short* s = (const LAS unsigned short*)(scr + (8 * c) * RS + nn * 2);
        unsigned e[8];
#pragma unroll
        for (int i = 0; i < 8; ++i) e[i] = s[i * (RS / 2)];
        u32x4 o; o.x = e[0] | (e[1] << 16); o.y = e[2] | (e[3] << 16); o.z = e[4] | (e[5] << 16); o.w = e[6] | (e[7] << 16);
        __builtin_nontemporal_store(o, (GAS u32x4*)(dst + (size_t)(dst_n0 + nn) * K + k0 + 8 * c));
    }
    asm volatile("s_waitcnt lgkmcnt(0)" ::: "memory");
}

constexpr int CV_GU = 2816, CV_DN = 1408, CV_QKV = 1536, CV_MO = 512, CV_RIN = 2048, CV_RO = 512;
constexpr int CV_P0 = 0, CV_MB = CV_GU + CV_DN + CV_QKV, CV_RT = CV_MB + CV_MO + 2 * CV_GU + 2 * CV_DN + CV_RIN, CV_END = CV_RT + CV_RO + CV_GU + CV_DN;
static_assert(CV_MB == 5760 && CV_RT == 16768 && CV_END == 21504, "conversion items");
struct ConvPtrs { const GAS float* gu; const GAS float* dn; const GAS float* qkv; const GAS float* mo; const GAS float* rin; const GAS float* ro; const GAS float* gain;
                  GAS bf16_t* WGU; GAS bf16_t* WDN; GAS bf16_t* WQKV; GAS bf16_t* WMO; GAS bf16_t* WRIN; GAS bf16_t* WRO; };
__device__ __forceinline__ void conv_item(const ConvPtrs& P, int it, LAS unsigned char* scr, int lane) {
    int mt, mi = 0, r = it;
    if (r < CV_MB) { if (r < CV_GU) { mt = 0; mi = 0; } else if ((r -= CV_GU) < CV_DN) { mt = 1; mi = 0; } else { r -= CV_DN; mt = 2; } }
    else if (r < CV_RT) { r -= CV_MB;
        if (r < CV_MO) mt = 3; else if ((r -= CV_MO) < CV_GU) { mt = 0; mi = 1; } else if ((r -= CV_GU) < CV_DN) { mt = 1; mi = 1; } else if ((r -= CV_DN) < CV_GU) { mt = 0; mi = 2; }
        else if ((r -= CV_GU) < CV_DN) { mt = 1; mi = 2; } else { r -= CV_DN; mt = 4; } }
    else { r -= CV_RT; if (r < CV_RO) mt = 5; else if ((r -= CV_RO) < CV_GU) { mt = 0; mi = 3; } else { r -= CV_GU; mt = 1; mi = 3; } }
    if (mt == 0) { const int kb = r / 88, nb = r % 88; const int L = mi >> 1, f = mi & 1;
        xpose_item(P.gu + (size_t)mi * GU_ELEMS, DMODEL, 2 * FFN, P.WGU + (size_t)mi * GU_ELEMS, P.gain + (L * 3 + (f ? 2 : 0)) * DMODEL, ((nb & 1) * 44 + (nb >> 1)) * 128, nb * 128, kb * 64, scr, lane); }
    else if (mt == 1) { const int kb = r / 16, nb = r % 16; xpose_item(P.dn + (size_t)mi * DN_ELEMS, FFN, DMODEL, P.WDN + (size_t)mi * DN_ELEMS, nullptr, nb * 128, nb * 128, kb * 64, scr, lane); }
    else if (mt == 2) { const int kb = r / 48, nb = r % 48; xpose_item(P.qkv, DMODEL, NQKV, P.WQKV, P.gain + (0 * 3 + 1) * DMODEL, nb * 128, nb * 128, kb * 64, scr, lane); }
    else if (mt == 3) { const int kb = r / 16, nb = r % 16; xpose_item(P.mo, DMODEL, DMODEL, P.WMO, nullptr, nb * 128, nb * 128, kb * 64, scr, lane); }
    else if (mt == 4) { const int kb = r / 64, nb = r % 64; xpose_item(P.rin, DMODEL, NRIN, P.WRIN, P.gain + (1 * 3 + 1) * DMODEL, nb * 128, nb * 128, kb * 64, scr, lane); }
    else { const int kb = r / 16, nb = r % 16; xpose_item(P.ro, DMODEL, DMODEL, P.WRO, nullptr, nb * 128, nb * 128, kb * 64, scr, lane); }
}

#define XB_TMO      128
#define XB_XCNT(j)  (256  + 64 * (j))
#define XB_XSUB(j)  (1280 + 64 * (j))
#define XB_XGEN(j)  (2304 + 64 * (j))
#define XB_TOP      3328
#define XB_TOPGEN   3392
#define XCD_BAR_WORDS 3456
#define XB_SPIN_CAP (1u << 22)
__device__ __forceinline__ unsigned xb_ld(unsigned* p)              { return __hip_atomic_load(p, __ATOMIC_RELAXED, __HIP_MEMORY_SCOPE_AGENT); }
__device__ __forceinline__ unsigned xb_add(unsigned* p, unsigned v) { return __hip_atomic_fetch_add(p, v, __ATOMIC_RELAXED, __HIP_MEMORY_SCOPE_AGENT); }
__device__ __forceinline__ unsigned xb_xcc_id() { return (unsigned)__builtin_amdgcn_s_getreg((3 << 11) | 20) & 0xFu; }
#define XB_SPIN(cond, bar) do { unsigned _sp = 0; while (cond) { __builtin_amdgcn_s_sleep(1); \
    if ((++_sp & 255u) == 0u) { if (xb_ld(&(bar)[XB_TMO])) break; if (_sp > XB_SPIN_CAP) { atomicAdd(&(bar)[XB_TMO], 1u); break; } } } } while (0)
struct XcdBarrier { unsigned* bar; unsigned x; volatile LAS unsigned* st; };
__device__ __forceinline__ XcdBarrier xcd_barrier_post(unsigned* bar, volatile LAS unsigned* st) {
    XcdBarrier b; b.bar = bar; b.x = xb_xcc_id(); b.st = st;
    if (threadIdx.x == 0) (void)xb_add(&bar[XB_XCNT(b.x)], 1u);
    return b;
}
__device__ __forceinline__ void xcd_barrier_complete(unsigned* bar, unsigned x, unsigned& nloc, unsigned& nx) {
    const unsigned G = gridDim.x * gridDim.y * gridDim.z;
    unsigned sum, cnt, mine, sp = 0u;
    for (;;) {
        sum = 0u; cnt = 0u; mine = 0u;
#pragma unroll
        for (unsigned j = 0; j < 16; ++j) { const unsigned c = xb_ld(&bar[XB_XCNT(j)]); sum += c; cnt += (c > 0u) ? 1u : 0u; mine = (j == x) ? c : mine; }
        if (sum == G) break;
        __builtin_amdgcn_s_sleep(1);
        if ((++sp & 255u) == 0u) { if (xb_ld(&bar[XB_TMO])) break; if (sp > XB_SPIN_CAP) { atomicAdd(&bar[XB_TMO], 1u); break; } }
    }
    nloc = mine > 0u ? mine : 1u; nx = cnt > 0u ? cnt : 1u;
}
__device__ __forceinline__ void xcd_barrier(const XcdBarrier& b) {
    asm volatile("s_waitcnt vmcnt(0)" ::: "memory");
    __syncthreads();
    if (threadIdx.x == 0) {
        unsigned* bar = b.bar;
        __builtin_amdgcn_s_waitcnt(0);
        unsigned nloc = b.st[0], nx = b.st[1];
        if (nloc == 0u) { xcd_barrier_complete(bar, b.x, nloc, nx); b.st[0] = nloc; b.st[1] = nx; }
        const unsigned old = xb_add(&bar[XB_XSUB(b.x)], 1u);
        const unsigned gen = old / nloc;
        if (old + 1u == (gen + 1u) * nloc) {
            __builtin_amdgcn_fence(__ATOMIC_RELEASE, "agent");
            asm volatile("s_waitcnt vmcnt(0)" ::: "memory");
            const unsigned og = xb_add(&bar[XB_TOP], 1u);
            const unsigned tg = og / nx;
            if (og + 1u == (tg + 1u) * nx) xb_add(&bar[XB_TOPGEN], 1u);
            else XB_SPIN(xb_ld(&bar[XB_TOPGEN]) == tg, bar);
            __builtin_amdgcn_fence(__ATOMIC_ACQUIRE, "agent");
            xb_add(&bar[XB_XGEN(b.x)], 1u);
            asm volatile("s_waitcnt vmcnt(0)" ::: "memory");
        } else {
            XB_SPIN(xb_ld(&bar[XB_XGEN(b.x)]) == gen, bar);
            __builtin_amdgcn_fence(__ATOMIC_ACQUIRE, "agent");
            asm volatile("s_waitcnt vmcnt(0)" ::: "memory");
        }
    }
    __syncthreads();
}

struct Args { const float* in[10]; float* out; unsigned char* ws; int ph_lo, ph_hi, coop, pad; };

__global__ void __launch_bounds__(NTHREADS, 2) mk_fwd(Args args) {
    extern __shared__ __attribute__((aligned(16))) unsigned char lds_raw[];
    LAS unsigned char* lds = (LAS unsigned char*)lds_raw;
    volatile LAS unsigned* bst = (volatile LAS unsigned*)(lds + LDS_BYTES - 64);
    if (threadIdx.x < 2) bst[threadIdx.x] = 0u;
    __syncthreads();
    XcdBarrier xbar; xbar.bar = (unsigned*)(args.ws + WS_BAR); xbar.x = 0; xbar.st = bst;
    if (args.coop) xbar = xcd_barrier_post((unsigned*)(args.ws + WS_BAR), bst);
    int dup_done = 0;
    for (int ph = args.ph_lo; ph < args.ph_hi; ++ph) {
      for (int sub = 0; sub < 3; ++sub) {
        int tid = threadIdx.x; asm volatile("" : "+v"(tid));
        const int lane = tid & 63, wave = __builtin_amdgcn_readfirstlane(tid >> 6);
        int G = gridDim.x, bx = blockIdx.x; asm volatile("" : "+s"(G), "+s"(bx));
        const int vcu = (G % 8 == 0) ? (bx % 8) * (G / 8) + bx / 8 : bx;
        GAS unsigned char* ws = (GAS unsigned char*)args.ws; asm volatile("" : "+s"(ws));
        GAS u64* SS = (GAS u64*)(ws + WS_SS);
        GAS float* KSUM = (GAS float*)(ws + WS_KSUM);
        GAS bf16_t* WGU = (GAS bf16_t*)(ws + WS_WGU); GAS bf16_t* WDN = (GAS bf16_t*)(ws + WS_WDN); GAS bf16_t* WQKV = (GAS bf16_t*)(ws + WS_WQKV); GAS bf16_t* WMO = (GAS bf16_t*)(ws + WS_WMO);
        GAS bf16_t* WRIN = (GAS bf16_t*)(ws + WS_WRIN); GAS bf16_t* WRO = (GAS bf16_t*)(ws + WS_WRO);
        GAS bf16_t* XB = (GAS bf16_t*)(ws + WS_XB); GAS bf16_t* ACT = (GAS bf16_t*)(ws + WS_ACT); GAS bf16_t* QKV = (GAS bf16_t*)(ws + WS_QKV); GAS bf16_t* AO = (GAS bf16_t*)(ws + WS_AO);
        const GAS float* x_in = ((const GAS float*)args.in[0]); const GAS float* norm_gain = ((const GAS float*)args.in[1]);
        GAS float* out = ((GAS float*)args.out);
        if (sub != 1) {
            int c_lo = 0, c_hi = 0, widx = 0, nw = 1;
            if (ph == 0 && sub == 2) { c_lo = CV_P0; c_hi = CV_GU; widx = vcu * NWAVES + wave; nw = G * NWAVES; }
            else if (ph == 1 && sub == 2 && 2 * bx >= G) { c_lo = CV_GU; c_hi = CV_MB; widx = (bx - (G >> 1)) * NWAVES + wave; nw = (G - (G >> 1)) * NWAVES; }
            else if (ph == 4 || ph == 11) {
                const int lo = (ph == 4) ? CV_MB : CV_RT, hi = (ph == 4) ? CV_RT : CV_END, mid = lo + ((hi - lo) >> 1);
                if (sub == 0 && (vcu & 1)) { c_lo = lo; c_hi = mid; } else if (sub == 2 && !(vcu & 1)) { c_lo = mid; c_hi = hi; }
                widx = (vcu >> 1) * NWAVES + wave; nw = (G >> 1) * NWAVES;
            }
            if (c_hi > c_lo) {
                ConvPtrs P{(const GAS float*)args.in[2], (const GAS float*)args.in[3], (const GAS float*)args.in[4], (const GAS float*)args.in[5], (const GAS float*)args.in[6], (const GAS float*)args.in[7], norm_gain,
                           WGU, WDN, WQKV, WMO, WRIN, WRO};
                LAS unsigned char* scr = lds + wave * 16640;
                for (int it = c_lo + widx; it < c_hi; it += nw) conv_item(P, it, scr, lane);
            }
            __syncthreads();
        } else if (ph == 0 && (PH_MASK & 1)) {
            const int gw = vcu * NWAVES + wave, NGW = G * NWAVES;
            for (int m = gw; m < MTOK; m += NGW) {
                const GAS f32x4* xr = (const GAS f32x4*)(x_in + (size_t)m * DMODEL) + lane;
                GAS u32x2* o8 = (GAS u32x2*)(XB + (size_t)m * DMODEL) + lane;
                float s = 0.f;
#pragma unroll
                for (int j = 0; j < 8; ++j) { const f32x4 v = __builtin_nontemporal_load(xr + 64 * j); s += (v[0] * v[0] + v[1] * v[1]) + (v[2] * v[2] + v[3] * v[3]); u32x2 wv; wv.x = cvtpk(v[0], v[1]); wv.y = cvtpk(v[2], v[3]); o8[64 * j] = wv; }
                s = wave_sum(s);
                if (lane == 0) SS[m] = ss_enc(s);
            }
            for (int i = bx * NTHREADS + tid; i < 6 * MTOK; i += G * NTHREADS) SS[MTOK + i] = 0ull;
            for (int i = bx * NTHREADS + tid; i < 32 * DMODEL; i += G * NTHREADS) KSUM[i] = 0.f;
        } else if (ph == 15 && (PH_MASK & 2)) {
            const GAS float* fn = ((const GAS float*)args.in[9]); const GAS u64* ssf = SS + 6 * MTOK;
            for (int i = bx * NTHREADS + tid; i < MTOK * (DMODEL / 4); i += G * NTHREADS) {
                const int row = i >> 9, c4 = i & 511;
                const float rs = __builtin_amdgcn_rsqf(ss_dec(ssf[row]) * (1.0f / DMODEL) + RMS_EPS);
                const u32x2 bb = ((const GAS u32x2*)XB)[i]; const f32x4 gg = ((const GAS f32x4*)fn)[c4];
                f32x4 v = (f32x4){__builtin_bit_cast(float, bb.x << 16), __builtin_bit_cast(float, bb.x & 0xffff0000u), __builtin_bit_cast(float, bb.y << 16), __builtin_bit_cast(float, bb.y & 0xffff0000u)};
                v = v * rs * gg; __builtin_nontemporal_store(v, (GAS f32x4*)out + i);
            }
        } else {
            const int L = (ph - 1) / 7, step = (ph - 1) % 7;
            if ((step == 0 || step == 5) && (PH_MASK & 4)) {
                const int f = (step == 5);
                pg8::Gemm gm{XB, WGU + (size_t)(L * 2 + f) * GU_ELEMS, MTOK, 2 * FFN, DMODEL};
                pg8::StaticOrder S; S.init(MTOK, 2 * FFN, G, bx);
                pg8::EpiGU E{ACT, SS + (size_t)(3 * L + (f ? 2 : 0)) * MTOK};
                pg8::gemm_phase<pg8::EpiGU, pg8::StaticOrder, true, true>(lds, gm, S, E, tid);
            } else if ((step == 1 || step == 6 || step == 4) && (PH_MASK & 8)) {
                pg8::Gemm gm; pg8::EpiRes E;
                if (step == 4) { gm = pg8::Gemm{AO, L == 0 ? WMO : WRO, MTOK, DMODEL, DMODEL}; E = pg8::EpiRes{XB, SS + (size_t)(3 * L + 2) * MTOK, 1.0f}; }
                else { const int f = (step == 6); gm = pg8::Gemm{ACT, WDN + (size_t)(L * 2 + f) * DN_ELEMS, MTOK, DMODEL, FFN};
                       E = pg8::EpiRes{XB, SS + (size_t)(3 * L + (f ? 3 : 1)) * MTOK, 0.5f}; }
                pg8::StaticOrder S; S.init(MTOK, DMODEL, G, bx);
                pg8::gemm_phase<pg8::EpiRes, pg8::StaticOrder, true, true>(lds, gm, S, E, tid);
            } else if (step == 2) {
                if (L == 0 && (PH_MASK & 16)) {
                    pg8::Gemm gm{XB, WQKV, MTOK, NQKV, DMODEL}; pg8::StaticOrder S; S.init(MTOK, NQKV, G, bx);
                    pg8::EpiQKV E{QKV, SS + 1 * MTOK, KSUM};
                    pg8::gemm_phase<pg8::EpiQKV, pg8::StaticOrder, true, true>(lds, gm, S, E, tid);
                } else if (PH_MASK & 32) {
                    pg8::Gemm gm{XB, WRIN, MTOK, NRIN, DMODEL}; pg8::StaticOrder S; S.init(MTOK, NRIN, G, bx);
                    pg8::EpiRIN E{QKV, SS + 4 * MTOK};
                    pg8::gemm_phase<pg8::EpiRIN, pg8::StaticOrder, true, true>(lds, gm, S, E, tid);
                }
            } else {
                if (L == 0 && (PH_MASK & 64)) {
                    for (int p = vcu; p < 256; p += G) {
                        const int bh = p >> 2, s = p & 3, b = bh >> 4, h = bh & 15;
                        const GAS bf16_t* Qb = QKV + (size_t)b * SEQ * NQKV + h * 128;
                        for (int e = 0; e < 2; ++e) {
                            const int qb = e ? 7 - s : s;
                            moba_unit256(lds, Qb, Qb + 2048, Qb + 4096, qb, AO + (size_t)b * SEQ * DMODEL + h * 128, KSUM + (size_t)b * 8 * DMODEL + h * 128, tid);
                        }
                    }
                } else if (PH_MASK & 128) {
                    const GAS float* gnp = ((const GAS float*)args.in[8]);
                    for (int p = vcu; p < 256; p += G) {
                        const int bh = p >> 3, s = p & 7, b = bh >> 3, h = bh & 7;
                        const GAS bf16_t* Qb = QKV + (size_t)b * SEQ * NRIN + h * 256;
                        const float lg2 = __builtin_amdgcn_logf(1.0f - __builtin_amdgcn_exp2f(-5.0f - (float)h));
                        for (int e = 0; e < 2; ++e) {
                            const int u = e ? 15 - s : s;
                            attn_unit<256, 256, false>(lds, Qb, Qb + 2048, Qb + 4096, NRIN, u * 128, AO + (size_t)b * SEQ * DMODEL + h * 256,
                                                       nullptr, lg2, Qb + 6144, gnp + h * 256, tid);
                        }
                    }
                }
            }
        }
      }
        if (PROBE_DUP != 0 && ((PROBE_DUP >> ph) & 1) && !dup_done) { dup_done = 1; --ph; } else dup_done = 0;
        if (ph + 1 < args.ph_hi) {
            if (args.coop) {
                if (args.coop == 2) {
                    asm volatile("s_waitcnt vmcnt(0) lgkmcnt(0)" ::: "memory");
                    cg::this_grid().sync();
                    __builtin_amdgcn_fence(__ATOMIC_ACQUIRE, "agent");
                    asm volatile("s_waitcnt vmcnt(0)" ::: "memory");
                } else xcd_barrier(xbar);
            }
        }
    }
}

extern "C" void kernel_launch(void* const* d_in, const int* in_sizes, int n_in, void* d_out, int out_size, void* d_ws, size_t ws_size, hipStream_t stream) {
    static int grid = 0;
    if (grid == 0) {
        if (n_in != 10 || ws_size < WS_END) { fprintf(stderr, "kernel_launch: unexpected inputs (n_in %d, ws %zu)\n", n_in, ws_size); grid = -1; return; }
        int dev = 0, cus = 0, per_cu = 0;
        hipGetDevice(&dev);
        hipDeviceGetAttribute(&cus, hipDeviceAttributeMultiprocessorCount, dev);
        if (hipFuncSetAttribute((const void*)mk_fwd, hipFuncAttributeMaxDynamicSharedMemorySize, LDS_BYTES) != hipSuccess) { fprintf(stderr, "kernel_launch: hipFuncSetAttribute failed\n"); grid = -1; return; }
        if (hipOccupancyMaxActiveBlocksPerMultiprocessor(&per_cu, (const void*)mk_fwd, NTHREADS, LDS_BYTES) != hipSuccess || per_cu < 1) { fprintf(stderr, "kernel_launch: occupancy query says %d\n", per_cu); per_cu = 1; }
        (void)hipGetLastError();
        grid = cus * 1;
    }
    if (grid < 0) return;
    Args a{};
    for (int i = 0; i < 10; ++i) a.in[i] = (const float*)d_in[i];
    a.out = (float*)d_out; a.ws = (unsigned char*)d_ws; a.pad = 0;
#if MK_ONE_LAUNCH
    if (hipMemsetAsync((char*)d_ws + WS_BAR, 0, XCD_BAR_WORDS * 4, stream) != hipSuccess) { fprintf(stderr, "kernel_launch: memset of barrier words failed\n"); return; }
    a.ph_lo = 0; a.ph_hi = 16; a.coop = 1;
    void* kargs[] = {&a};
    hipError_t e = hipLaunchCooperativeKernel((const void*)mk_fwd, dim3(grid), dim3(NTHREADS), kargs, LDS_BYTES, stream);
    if (e != hipSuccess) fprintf(stderr, "cooperative launch failed: %s (grid %d)\n", hipGetErrorString(e), grid);
#else
    for (int ph = 0; ph < 16; ++ph) {
        a.ph_lo = ph; a.ph_hi = ph + 1; a.coop = 0;
        hipLaunchKernelGGL(mk_fwd, dim3(grid), dim3(NTHREADS), LDS_BYTES, stream, a);
    }
#endif
}
```
